# Optimizing an MI355X kernel written in HIP

```python
import jax, jax.numpy as jnp
from jax import lax
import numpy as np

D_MODEL = 1024
BATCH = 4
SEQ = 4096
DEPTH = 4

HEAD_DIM = 128
MOBA_HEADS = 4
RET_HEADS = 4
MOBA_BLOCK = 256
MOBA_TOPK = 3
MOBA_QCHUNK = 32
RET_CHUNK = 128
CONV_WIDTH = 3
PEER_HEADS = 8
PEER_NKEYS = 128
PEER_NEXPERTS = PEER_NKEYS * PEER_NKEYS
PEER_TOPK = 16
PEER_DKEY = 256
PEER_TOKCHUNK = 128
ROPE_THETA = 10000.0
EPS = 1e-6
N_EVEN = (DEPTH + 1) // 2
N_ODD = DEPTH // 2
MOBA_W = MOBA_HEADS * HEAD_DIM
RET_W = RET_HEADS * HEAD_DIM
EVEN_SPLITS = (MOBA_W, MOBA_W, MOBA_W, RET_W, RET_W, RET_W, RET_W)
EVEN_IN = sum(EVEN_SPLITS)
EVEN_OUT_IN = MOBA_W + RET_W

kernel_name = "moba_retention_shortconv_peer_hybrid"


def rmsnorm(x, g):
    xf = x.astype(jnp.float32)
    y = xf * lax.rsqrt(jnp.mean(xf * xf, axis=-1, keepdims=True) + EPS)
    return (y * g.astype(jnp.float32)).astype(x.dtype)


def rope(t):
    s, dh = t.shape[2], t.shape[3]
    half = dh // 2
    inv = ROPE_THETA ** (-jnp.arange(half, dtype=jnp.float32) / half)
    ang = jnp.arange(s, dtype=jnp.float32)[:, None] * inv[None, :]
    cos = jnp.cos(ang).astype(t.dtype)
    sin = jnp.sin(ang).astype(t.dtype)
    t1, t2 = t[..., :half], t[..., half:]
    return jnp.concatenate([t1 * cos - t2 * sin, t2 * cos + t1 * sin], axis=-1)


def split_heads(t, n):
    b, s, _ = t.shape
    return t.reshape(b, s, n, HEAD_DIM).transpose(0, 2, 1, 3)


def merge_heads(t):
    b, h, s, dh = t.shape
    return t.transpose(0, 2, 1, 3).reshape(b, s, h * dh)


def moba_attention(q, k, v):
    b, h, s, dh = q.shape
    nb = -(-s // MOBA_BLOCK)
    pad = nb * MOBA_BLOCK - s
    kb = jnp.pad(k, ((0, 0), (0, 0), (0, pad), (0, 0))).reshape(b, h, nb, MOBA_BLOCK, dh)
    vb = jnp.pad(v, ((0, 0), (0, 0), (0, pad), (0, 0))).reshape(b, h, nb, MOBA_BLOCK, dh)
    counts = jnp.minimum(MOBA_BLOCK, s - jnp.arange(nb) * MOBA_BLOCK).astype(jnp.float32)
    kmean = kb.astype(jnp.float32).sum(axis=3) / counts[None, None, :, None]
    gate = jnp.einsum('bhsd,bhnd->bhsn', q.astype(jnp.float32), kmean)
    qblk = jnp.arange(s) // MOBA_BLOCK
    past = jnp.arange(nb)[None, :] < qblk[:, None]
    gate = jnp.where(past, gate, -jnp.inf)
    kk = min(MOBA_TOPK, nb)
    _, sel = lax.top_k(gate, kk)
    valid = sel < qblk[:, None]
    nq = s // MOBA_QCHUNK
    def chunked(t):
        return t.reshape(b, h, nq, MOBA_QCHUNK, *t.shape[3:]).transpose(2, 0, 1, 3, *range(4, t.ndim + 1))
    qs, sels, valids = chunked(q), chunked(sel), chunked(valid)
    scale = dh ** -0.5
    bi = jnp.arange(b)[:, None, None, None]
    hi = jnp.arange(h)[None, :, None, None]

    def step(args):
        ci, qc, selc, validc = args
        tpos = ci * MOBA_QCHUNK + jnp.arange(MOBA_QCHUNK)
        ob = (ci * MOBA_QCHUNK) // MOBA_BLOCK
        k_own = lax.dynamic_index_in_dim(kb, ob, axis=2, keepdims=False)
        v_own = lax.dynamic_index_in_dim(vb, ob, axis=2, keepdims=False)
        kpos = ob * MOBA_BLOCK + jnp.arange(MOBA_BLOCK)
        s_own = jnp.einsum('bhqd,bhkd->bhqk', qc, k_own).astype(jnp.float32) * scale
        s_own = jnp.where(kpos[None, :] <= tpos[:, None], s_own, -jnp.inf)
        kg = kb[bi, hi, selc]
        vg = vb[bi, hi, selc]
        s_sel = jnp.einsum('bhqd,bhqjkd->bhqjk', qc, kg).astype(jnp.float32) * scale
        s_sel = jnp.where(validc[..., None], s_sel, -jnp.inf)
        scores = jnp.concatenate([s_sel.reshape(b, h, MOBA_QCHUNK, kk * MOBA_BLOCK), s_own], axis=-1)
        p = jax.nn.softmax(scores, axis=-1).astype(v.dtype)
        p_sel = p[..., :kk * MOBA_BLOCK].reshape(b, h, MOBA_QCHUNK, kk, MOBA_BLOCK)
        p_own = p[..., kk * MOBA_BLOCK:]
        return (jnp.einsum('bhqjk,bhqjkd->bhqd', p_sel, vg)
                + jnp.einsum('bhqk,bhkd->bhqd', p_own, v_own))

    out = lax.map(step, (jnp.arange(nq), qs, sels, valids))
    return out.transpose(1, 2, 0, 3, 4).reshape(b, h, s, dh)


def retention(q, k, v):
    b, h, s, dh = q.shape
    c = RET_CHUNK
    nc = s // c
    log_g = jnp.log(1.0 - 2.0 ** (-5.0 - jnp.arange(h, dtype=jnp.float32)))
    idx = jnp.arange(c, dtype=jnp.float32)
    diff = idx[:, None] - idx[None, :]
    dmask = jnp.where(diff >= 0, jnp.exp(log_g[:, None, None] * jnp.maximum(diff, 0.0)), 0.0)
    xi = jnp.exp(log_g[:, None] * (idx + 1.0))[..., None]
    zeta = jnp.exp(log_g[:, None] * (c - 1.0 - idx))[..., None]
    gc = jnp.exp(log_g * c)[:, None, None]
    def chunked(t):
        return t.astype(jnp.float32).reshape(b, h, nc, c, dh).transpose(2, 0, 1, 3, 4)
    qs, ks, vs = chunked(q), chunked(k * (dh ** -0.5)), chunked(v)

    def step(state, inp):
        qc, kc, vc = inp
        inner = jnp.einsum('bhnd,bhmd->bhnm', qc, kc) * dmask
        o = jnp.einsum('bhnm,bhmd->bhnd', inner, vc) + jnp.einsum('bhnd,bhde->bhne', qc, state) * xi
        state = state * gc + jnp.einsum('bhmd,bhme->bhde', kc * zeta, vc)
        return state, o

    state0 = jnp.zeros((b, h, dh, dh), jnp.float32)
    _, outs = lax.scan(step, state0, (qs, ks, vs))
    return outs.transpose(1, 2, 0, 3, 4).reshape(b, h, s, dh)


def attn_retention_mixer(xn, w_in, w_out):
    proj = xn @ w_in
    cuts = list(np.cumsum(EVEN_SPLITS)[:-1])
    mq, mk, mv, rq, rk, rv, rg = jnp.split(proj, cuts, axis=-1)
    mq, mk, mv = split_heads(mq, MOBA_HEADS), split_heads(mk, MOBA_HEADS), split_heads(mv, MOBA_HEADS)
    rq, rk, rv = split_heads(rq, RET_HEADS), split_heads(rk, RET_HEADS), split_heads(rv, RET_HEADS)
    mo = merge_heads(moba_attention(rope(mq), rope(mk), mv))
    ro = retention(rope(rq), rope(rk), rv)
    ro = ro * lax.rsqrt(jnp.mean(ro * ro, axis=-1, keepdims=True) + EPS)
    ro = merge_heads(ro).astype(xn.dtype) * jax.nn.silu(rg)
    return jnp.concatenate([mo, ro], axis=-1) @ w_out


def short_conv_mixer(xn, w_in, conv_w, w_out):
    d = xn.shape[-1]
    bg, cg, hx = jnp.split(xn @ w_in, 3, axis=-1)
    u = cg * hx
    y = lax.conv_general_dilated(u, conv_w[:, None, :], window_strides=(1,),
                                 padding=[(CONV_WIDTH - 1, 0)],
                                 dimension_numbers=('NWC', 'WIO', 'NWC'),
                                 feature_group_count=d)
    return (bg * y) @ w_out


def peer(xn, w_q, sub_keys, u, v):
    b, s, d = xn.shape
    t = xn.reshape(b * s, d)
    n_tok = b * s
    q = (t @ w_q).reshape(n_tok, PEER_HEADS, 2, PEER_DKEY // 2)
    sc = jnp.einsum('thpd,hpnd->thpn', q, sub_keys).astype(jnp.float32)
    s1, i1 = lax.top_k(sc[:, :, 0], PEER_TOPK)
    s2, i2 = lax.top_k(sc[:, :, 1], PEER_TOPK)
    cand = (s1[..., :, None] + s2[..., None, :]).reshape(n_tok, PEER_HEADS, PEER_TOPK * PEER_TOPK)
    cidx = (i1[..., :, None] * PEER_NKEYS + i2[..., None, :]).reshape(n_tok, PEER_HEADS, PEER_TOPK * PEER_TOPK)
    top_s, pos = lax.top_k(cand, PEER_TOPK)
    eidx = jnp.take_along_axis(cidx, pos, axis=-1)
    gate = jax.nn.softmax(top_s, axis=-1).astype(xn.dtype)
    nt = n_tok // PEER_TOKCHUNK

    def step(args):
        tc, ec, gc = args
        hid = jax.nn.gelu(jnp.einsum('td,thkd->thk', tc, u[ec]), approximate=False)
        return jnp.einsum('thk,thkd->td', gc * hid, v[ec])

    out = lax.map(step, (t.reshape(nt, PEER_TOKCHUNK, d),
                         eidx.reshape(nt, PEER_TOKCHUNK, PEER_HEADS, PEER_TOPK),
                         gate.reshape(nt, PEER_TOKCHUNK, PEER_HEADS, PEER_TOPK)))
    return out.reshape(b, s, d)


def setup_inputs(seed: int = 0) -> dict:
    key = jax.random.key(seed)
    ks = jax.random.split(key, 16)
    f32 = jnp.float32
    nrm = lambda k, shape, sc: jax.random.normal(k, shape, f32) * sc
    return {
        "x": nrm(ks[0], (BATCH, SEQ, D_MODEL), 1.0),
        "norm_mix": 1.0 + nrm(ks[1], (DEPTH, D_MODEL), 0.02),
        "norm_ffn": 1.0 + nrm(ks[2], (DEPTH, D_MODEL), 0.02),
        "even_w_in": nrm(ks[3], (N_EVEN, D_MODEL, EVEN_IN), D_MODEL ** -0.5),
        "even_w_out": nrm(ks[4], (N_EVEN, EVEN_OUT_IN, D_MODEL), EVEN_OUT_IN ** -0.5),
        "odd_w_in": nrm(ks[5], (N_ODD, D_MODEL, 3 * D_MODEL), D_MODEL ** -0.5),
        "odd_conv": nrm(ks[6], (N_ODD, CONV_WIDTH, D_MODEL), CONV_WIDTH ** -0.5),
        "odd_w_out": nrm(ks[7], (N_ODD, D_MODEL, D_MODEL), D_MODEL ** -0.5),
        "peer_w_q": nrm(ks[8], (DEPTH, D_MODEL, PEER_HEADS * PEER_DKEY), D_MODEL ** -0.5),
        "peer_sub_keys": nrm(ks[9], (DEPTH, PEER_HEADS, 2, PEER_NKEYS, PEER_DKEY // 2), (PEER_DKEY // 2) ** -0.5),
        "peer_u": nrm(ks[10], (DEPTH, PEER_NEXPERTS, D_MODEL), D_MODEL ** -0.5),
        "peer_v": nrm(ks[11], (DEPTH, PEER_NEXPERTS, D_MODEL), 0.1),
        "final_norm": 1.0 + nrm(ks[12], (D_MODEL,), 0.02),
    }


def reference(x, norm_mix, norm_ffn, even_w_in, even_w_out, odd_w_in, odd_conv, odd_w_out,
              peer_w_q, peer_sub_keys, peer_u, peer_v, final_norm):
    h = x
    for layer in range(DEPTH):
        xn = rmsnorm(h, norm_mix[layer])
        i = layer // 2
        if layer % 2 == 0:
            h = h + attn_retention_mixer(xn, even_w_in[i], even_w_out[i])
        else:
            h = h + short_conv_mixer(xn, odd_w_in[i], odd_conv[i], odd_w_out[i])
        h = h + peer(rmsnorm(h, norm_ffn[layer]), peer_w_q[layer], peer_sub_keys[layer],
                     peer_u[layer], peer_v[layer])
    return rmsnorm(h, final_norm)
```

```cpp
#include <hip/hip_runtime.h>
#include <hip/hip_cooperative_groups.h>
#include <cstdio>
namespace cg = cooperative_groups;

typedef unsigned short bf16_t;
typedef short bf16x8 __attribute__((ext_vector_type(8)));
typedef float f32x4 __attribute__((ext_vector_type(4)));
typedef unsigned u32x4 __attribute__((ext_vector_type(4)));
typedef unsigned u32x2 __attribute__((ext_vector_type(2)));
typedef float f32x2 __attribute__((ext_vector_type(2)));
typedef int i32x8 __attribute__((ext_vector_type(8)));
__device__ __forceinline__ f32x4 MAKEF4(float a, float b, float c, float d) { f32x4 r = {a, b, c, d}; return r; }

#ifndef STOP
#define STOP 99
#endif
#ifndef REP_E
#define REP_E 1
#endif
#ifndef REP_B1
#define REP_B1 1
#endif
#ifndef REP_A
#define REP_A 1
#endif
#ifndef REP_B3
#define REP_B3 1
#endif
#ifndef REP_F
#define REP_F 1
#endif
#define T_TOK 16384
#define DM 1024
#define SEQL 4096

constexpr size_t OFF_BAR   = 0;
constexpr size_t OFF_COS   = 16384;
constexpr size_t OFF_SIN   = OFF_COS + 4096ull * 64 * 4;
constexpr size_t OFF_KPART = OFF_SIN + 4096ull * 64 * 4;
constexpr size_t OFF_WEIN  = OFF_KPART + 256ull * 4 * 128 * 4;
constexpr size_t OFF_WEOUT = OFF_WEIN + 2ull * 3584 * 1024 * 2;
constexpr size_t OFF_WOIN  = OFF_WEOUT + 2ull * 1024 * 2048 * 2;
constexpr size_t OFF_WOOUT = OFF_WOIN + 2ull * 3072 * 1024 * 2;
constexpr size_t OFF_WPQ   = OFF_WOOUT + 2ull * 1024 * 1024 * 2;
constexpr size_t OFF_SUBK  = OFF_WPQ + 4ull * 2048 * 1024 * 2;
constexpr size_t OFF_U     = OFF_SUBK + 4ull * 8 * 2 * 128 * 128 * 2;
constexpr size_t OFF_V     = OFF_U + 4ull * 16384 * 1024 * 2;
constexpr size_t OFF_H     = OFF_V + 4ull * 16384 * 1024 * 2;
constexpr size_t OFF_XN    = OFF_H + 16384ull * 1024 * 4;
constexpr size_t OFF_R     = OFF_XN + 16384ull * 1024 * 2;
constexpr size_t R_BYTES   = 192ull << 20;
constexpr size_t OFF_AO    = OFF_R + R_BYTES;
constexpr size_t OFF_S     = OFF_AO + 16384ull * 2048 * 2;
constexpr size_t OFF_ST    = OFF_S + 16ull * 32 * 128 * 128 * 4;
constexpr size_t WS_NEED   = OFF_ST + 16ull * 32 * 128 * 128 * 2;
constexpr size_t HEADBUF = 16ull * 4096 * 128;
constexpr size_t R_MQ = 0, R_MK = HEADBUF, R_MVT = 2 * HEADBUF, R_RQ = 3 * HEADBUF, R_RK = 4 * HEADBUF,
                 R_RKT = 5 * HEADBUF, R_RVT = 6 * HEADBUF, R_RG = 7 * HEADBUF;
constexpr size_t R_SC_BYTES = 64ull << 20;

struct P {
  const float *x, *norm_mix, *norm_ffn, *even_w_in, *even_w_out, *odd_w_in, *odd_conv, *odd_w_out,
      *peer_w_q, *peer_sub_keys, *peer_u, *peer_v, *final_norm;
  float* out;
  char* ws;
};

__device__ __forceinline__ int otid() { int t = threadIdx.x; asm volatile("" : "+v"(t)); return t; }
typedef __attribute__((address_space(1))) char gchar_t;
__device__ __forceinline__ char* opaque(char* q) { size_t z = 0; asm volatile("" : "+s"(z)); return q + z; }
typedef __bf16 bf16x2_t __attribute__((ext_vector_type(2)));
__device__ __forceinline__ unsigned pk_bf16(float lo, float hi) {
  bf16x2_t v = {(__bf16)lo, (__bf16)hi};
  return __builtin_bit_cast(unsigned, v);
}
__device__ __forceinline__ bf16_t f2bf(float f) { return (bf16_t)(pk_bf16(f, 0.f) & 0xffffu); }
__device__ __forceinline__ float bf_lo(unsigned u) { return __uint_as_float(u << 16); }
__device__ __forceinline__ float bf_hi(unsigned u) { return __uint_as_float(u & 0xffff0000u); }
__device__ __forceinline__ float bf2f(bf16_t h) { return __uint_as_float(((unsigned)h) << 16); }

template <int CTRL>
__device__ __forceinline__ unsigned dpp_u(unsigned x) {
  return (unsigned)__builtin_amdgcn_update_dpp(0, (int)x, CTRL, 0xF, 0xF, false);
}
__device__ __forceinline__ unsigned rowmax_u(unsigned x) {
  unsigned y;
  y = dpp_u<0x121>(x); x = x > y ? x : y;
  y = dpp_u<0x122>(x); x = x > y ? x : y;
  y = dpp_u<0x124>(x); x = x > y ? x : y;
  y = dpp_u<0x128>(x); x = x > y ? x : y;
  return x;
}
__device__ __forceinline__ float rowsum_f(float x) {
  x += __uint_as_float(dpp_u<0x121>(__float_as_uint(x)));
  x += __uint_as_float(dpp_u<0x122>(__float_as_uint(x)));
  x += __uint_as_float(dpp_u<0x124>(__float_as_uint(x)));
  x += __uint_as_float(dpp_u<0x128>(__float_as_uint(x)));
  return x;
}
__device__ __forceinline__ float rdlane_f(float x, int l) {
  return __uint_as_float((unsigned)__builtin_amdgcn_readlane((int)__float_as_uint(x), l));
}
__device__ __forceinline__ float wavesum_f(float x) {
  x = rowsum_f(x);
  return rdlane_f(x, 0) + rdlane_f(x, 16) + rdlane_f(x, 32) + rdlane_f(x, 48);
}
__device__ __forceinline__ unsigned f_ord(float v) {
  unsigned u = __float_as_uint(v);
  return (u & 0x80000000u) ? ~u : (u | 0x80000000u);
}
__device__ __forceinline__ float f_deord(unsigned u) {
  return __uint_as_float((u & 0x80000000u) ? (u ^ 0x80000000u) : ~u);
}

#define XB_TMO 128
#define XB_XCNT(j) (256 + 64 * (j))
#define XB_XSUB(j) (1280 + 64 * (j))
#define XB_XGEN(j) (2304 + 64 * (j))
#define XB_TOP 3328
#define XB_TOPGEN 3392
#define XB_SPIN_CAP (1u << 22)
__device__ __forceinline__ unsigned xb_ld(unsigned* q) { return __hip_atomic_load(q, __ATOMIC_RELAXED, __HIP_MEMORY_SCOPE_AGENT); }
__device__ __forceinline__ unsigned xb_add(unsigned* q, unsigned v) { return __hip_atomic_fetch_add(q, v, __ATOMIC_RELAXED, __HIP_MEMORY_SCOPE_AGENT); }
#define XB_SPIN(cond, bar) do { unsigned _sp = 0; while (cond) { __builtin_amdgcn_s_sleep(1); \
    if ((++_sp & 255u) == 0u) { if (xb_ld(&(bar)[XB_TMO])) break; if (_sp > XB_SPIN_CAP) { atomicAdd(&(bar)[XB_TMO], 1u); break; } } } } while (0)
struct XB { unsigned* bar; unsigned x, nloc, nx; };
__device__ __forceinline__ void xb_complete(unsigned* bar, unsigned x, unsigned& nloc, unsigned& nx) {
  const unsigned G = gridDim.x;
  unsigned sum, cnt, mine, sp = 0u;
  for (;;) {
    sum = 0u; cnt = 0u; mine = 0u;
#pragma unroll
    for (unsigned j = 0; j < 16; ++j) { const unsigned c = xb_ld(&bar[XB_XCNT(j)]); sum += c; cnt += (c > 0u) ? 1u : 0u; mine = (j == x) ? c : mine; }
    if (sum == G) break;
    __builtin_amdgcn_s_sleep(1);
    if ((++sp & 255u) == 0u) { if (xb_ld(&bar[XB_TMO])) break; if (sp > XB_SPIN_CAP) { atomicAdd(&bar[XB_TMO], 1u); break; } }
  }
  nloc = mine > 0u ? mine : 1u; nx = cnt > 0u ? cnt : 1u;
}
__device__ __forceinline__ void gbar(XB& b) {
  asm volatile("s_waitcnt vmcnt(0) lgkmcnt(0)" ::: "memory");
  __syncthreads();
  if (threadIdx.x == 0) {
    unsigned* bar = b.bar;
    if (b.nloc == 0u) xb_complete(bar, b.x, b.nloc, b.nx);
    const unsigned nloc = b.nloc, nx = b.nx;
    const unsigned old = xb_add(&bar[XB_XSUB(b.x)], 1u);
    const unsigned gen = old / nloc;
    if (old + 1u == (gen + 1u) * nloc) {
      __builtin_amdgcn_fence(__ATOMIC_RELEASE, "agent");
      asm volatile("s_waitcnt vmcnt(0)" ::: "memory");
      const unsigned og = xb_add(&bar[XB_TOP], 1u);
      const unsigned tg = og / nx;
      if (og + 1u == (tg + 1u) * nx) xb_add(&bar[XB_TOPGEN], 1u);
      else XB_SPIN(xb_ld(&bar[XB_TOPGEN]) == tg, bar);
      __builtin_amdgcn_fence(__ATOMIC_ACQUIRE, "agent");
      xb_add(&bar[XB_XGEN(b.x)], 1u);
      asm volatile("s_waitcnt vmcnt(0)" ::: "memory");
    } else {
      XB_SPIN(xb_ld(&bar[XB_XGEN(b.x)]) == gen, bar);
      __builtin_amdgcn_fence(__ATOMIC_ACQUIRE, "agent");
      asm volatile("s_waitcnt vmcnt(0)" ::: "memory");
    }
  }
  __syncthreads();
}

template <int MI, bool SWAP, bool F8 = false>
__device__ __forceinline__ void gemm_core(const bf16_t* __restrict__ A, int lda, const bf16_t* __restrict__ B, int ldb,
                                          int K, char* smem, f32x4 (&acc)[MI][4]) {
  const int tid = otid(), lane = tid & 63, w = tid >> 6, wm = w >> 1, wn = w & 1;
  const int lr = tid >> 3, lc = tid & 7;
  const int li = lane & 15, g = lane >> 4;
  u32x4 ra[MI], rb[4];
  const bf16_t* ap = A + (size_t)lr * lda + lc * 8;
  const bf16_t* bp = B + (size_t)lr * ldb + lc * 8;
#pragma unroll
  for (int i = 0; i < MI; ++i)
#pragma unroll
    for (int j = 0; j < 4; ++j) acc[i][j] = (f32x4){0.f, 0.f, 0.f, 0.f};
  const int nk = K >> 6;
#pragma unroll
  for (int i = 0; i < MI; ++i) ra[i] = *(const u32x4*)(ap + (size_t)(32 * i) * lda);
#pragma unroll
  for (int i = 0; i < 4; ++i) rb[i] = *(const u32x4*)(bp + (size_t)(32 * i) * ldb);
  const int woff = lr * 128 + ((lc ^ (lr & 7)) << 4);
  const int xrow = (wm * 16 * MI + li) * 128;
  const int wrow = 32768 + (wn * 32 + li) * 128;
  for (int kt = 0; kt < nk; ++kt) {
    __syncthreads();
#pragma unroll
    for (int i = 0; i < MI; ++i) *(u32x4*)(smem + woff + i * 4096) = ra[i];
#pragma unroll
    for (int i = 0; i < 4; ++i) *(u32x4*)(smem + 32768 + woff + i * 4096) = rb[i];
    __syncthreads();
    if (kt + 1 < nk) {
#pragma unroll
      for (int i = 0; i < MI; ++i) ra[i] = *(const u32x4*)(ap + (size_t)(32 * i) * lda + (kt + 1) * 64);
#pragma unroll
      for (int i = 0; i < 4; ++i) rb[i] = *(const u32x4*)(bp + (size_t)(32 * i) * ldb + (kt + 1) * 64);
    }
    if (F8) {
      const int c0 = (g ^ (li & 7)) << 4, c1 = ((4 + g) ^ (li & 7)) << 4;
      i32x8 wf8[4];
#pragma unroll
      for (int j = 0; j < 4; ++j) {
        const char* rp = smem + wrow + ((j & 1) * 16 + (j >> 1) * 64) * 128;
        const u32x4 lo = *(const u32x4*)(rp + c0), hi = *(const u32x4*)(rp + c1);
        wf8[j] = (i32x8){(int)lo.x, (int)lo.y, (int)lo.z, (int)lo.w, (int)hi.x, (int)hi.y, (int)hi.z, (int)hi.w};
      }
#pragma unroll
      for (int i = 0; i < MI; ++i) {
        const char* rp = smem + xrow + i * 2048;
        const u32x4 lo = *(const u32x4*)(rp + c0), hi = *(const u32x4*)(rp + c1);
        const i32x8 xf8 = {(int)lo.x, (int)lo.y, (int)lo.z, (int)lo.w, (int)hi.x, (int)hi.y, (int)hi.z, (int)hi.w};
#pragma unroll
        for (int j = 0; j < 4; ++j)
          acc[i][j] = __builtin_amdgcn_mfma_scale_f32_16x16x128_f8f6f4(wf8[j], xf8, acc[i][j], 0, 0, 0, 0x77777777, 0, 0x7f7f7f7f);
      }
    } else {
#pragma unroll
    for (int kk = 0; kk < 2; ++kk) {
      const int ch = ((kk * 4 + g) ^ (li & 7)) << 4;
      bf16x8 xf[MI], wf[4];
#pragma unroll
      for (int j = 0; j < 4; ++j) wf[j] = *(const bf16x8*)(smem + wrow + ((j & 1) * 16 + (j >> 1) * 64) * 128 + ch);
#pragma unroll
      for (int i = 0; i < MI; ++i) xf[i] = *(const bf16x8*)(smem + xrow + i * 2048 + ch);
#pragma unroll
      for (int i = 0; i < MI; ++i)
#pragma unroll
        for (int j = 0; j < 4; ++j) {
          if (SWAP) acc[i][j] = __builtin_amdgcn_mfma_f32_16x16x32_bf16(xf[i], wf[j], acc[i][j], 0, 0, 0);
          else acc[i][j] = __builtin_amdgcn_mfma_f32_16x16x32_bf16(wf[j], xf[i], acc[i][j], 0, 0, 0);
        }
    }
    }
  }
}

#define EPI_COORDS                                                             \
  const int tid_ = otid(); const int lane = tid_ & 63, w = tid_ >> 6, wm = w >> 1, wn = w & 1; \
  const int li = lane & 15, g = lane >> 4;                                     \
  (void)wm; (void)wn; (void)li; (void)g;
#define NCOL(j) (((j) & 1) * 16 + wn * 32 + ((j) >> 1) * 64 + g * 4)
#define MROW(i) (wm * 16 * MI + (i) * 16 + li)
#define NCOLS(j) (((j) & 1) * 16 + wn * 32 + ((j) >> 1) * 64 + li)
#define MROWS(i) (wm * 16 * MI + (i) * 16 + g * 4)

template <int MI, bool F8 = false>
__device__ void gemm_tile_bf16(const bf16_t* A, int lda, const bf16_t* B, int ldb, int K, bf16_t* C, int ldc, char* smem) {
  f32x4 acc[MI][4];
  gemm_core<MI, false, F8>(A, lda, B, ldb, K, smem, acc);
  EPI_COORDS
#pragma unroll
  for (int i = 0; i < MI; ++i)
#pragma unroll
    for (int j = 0; j < 4; ++j) {
      u32x2 v;
      v.x = pk_bf16(acc[i][j][0], acc[i][j][1]);
      v.y = pk_bf16(acc[i][j][2], acc[i][j][3]);
      *(u32x2*)(C + (size_t)MROW(i) * ldc + NCOL(j)) = v;
    }
}
template <int MI>
__device__ void gemm_tile_fp8out(const bf16_t* A, int lda, const bf16_t* B, int ldb, int K, unsigned char* C, int ldc, float mul, char* smem) {
  f32x4 acc[MI][4];
  gemm_core<MI, false>(A, lda, B, ldb, K, smem, acc);
  EPI_COORDS
#pragma unroll
  for (int i = 0; i < MI; ++i)
#pragma unroll
    for (int j = 0; j < 4; ++j) {
      int wd = __builtin_amdgcn_cvt_pk_fp8_f32(acc[i][j][0] * mul, acc[i][j][1] * mul, 0, false);
      wd = __builtin_amdgcn_cvt_pk_fp8_f32(acc[i][j][2] * mul, acc[i][j][3] * mul, wd, true);
      *(int*)(C + (size_t)MROW(i) * ldc + NCOL(j)) = wd;
    }
}
template <bool ACCUM, int MI>
__device__ void gemm_tile_f32(const bf16_t* A, int lda, const bf16_t* B, int ldb, int K, float* C, int ldc, char* smem) {
  f32x4 acc[MI][4];
  gemm_core<MI, false>(A, lda, B, ldb, K, smem, acc);
  EPI_COORDS
#pragma unroll
  for (int i = 0; i < MI; ++i)
#pragma unroll
    for (int j = 0; j < 4; ++j) {
      f32x4* cp = (f32x4*)(C + (size_t)MROW(i) * ldc + NCOL(j));
      f32x4 v = acc[i][j];
      if (ACCUM) v += *cp;
      *cp = v;
    }
}

__device__ __constant__ float LOG2G[4] = {-0.04580368961312479f, -0.02272007650008353f, -0.011315313227834146f,
                                          -0.005646563141142063f};

__device__ void even_in_tile(const P& p, int li_even, int tm, int tn, char* smem) {
  constexpr int MI = 8;
  char* ws = opaque(p.ws);
  const bf16_t* A = (const bf16_t*)(ws + OFF_XN) + (size_t)tm * 256 * 1024;
  const bf16_t* B = (const bf16_t*)(ws + OFF_WEIN) + ((size_t)li_even * 3584 + (size_t)tn * 128) * 1024;
  const int seg = tn >> 2, hd = tn & 3;
  const int t0 = tm * 256, b = t0 >> 12, s0 = t0 & 4095, bh = b * 4 + hd;
  bf16_t* R = (bf16_t*)(ws + OFF_R);
  f32x4 acc[MI][4];
  if (seg == 2 || seg == 5) {
    gemm_core<MI, true>(A, 1024, B, 1024, 1024, smem, acc);
    EPI_COORDS
    bf16_t* dst = R + (seg == 2 ? R_MVT : R_RVT) + (size_t)bh * 128 * 4096;
#pragma unroll
    for (int i = 0; i < MI; ++i)
#pragma unroll
      for (int j = 0; j < 4; ++j) {
        u32x2 v;
        v.x = pk_bf16(acc[i][j][0], acc[i][j][1]);
        v.y = pk_bf16(acc[i][j][2], acc[i][j][3]);
        *(u32x2*)(dst + (size_t)NCOLS(j) * 4096 + s0 + MROWS(i)) = v;
      }
    return;
  }
  gemm_core<MI, false>(A, 1024, B, 1024, 1024, smem, acc);
  EPI_COORDS
  if (seg != 6) {
    const float* ctab = (const float*)(ws + OFF_COS);
    const float* stab = (const float*)(ws + OFF_SIN);
#pragma unroll
    for (int i = 0; i < MI; ++i) {
      const int s = s0 + MROW(i);
#pragma unroll
      for (int jj = 0; jj < 2; ++jj) {
        const int d = wn * 32 + jj * 16 + g * 4;
        const f32x4 c = *(const f32x4*)(ctab + s * 64 + d);
        const f32x4 sn = *(const f32x4*)(stab + s * 64 + d);
#pragma unroll
        for (int r = 0; r < 4; ++r) {
          const float a = acc[i][jj][r], bb = acc[i][jj + 2][r];
          acc[i][jj][r] = a * c[r] - bb * sn[r];
          acc[i][jj + 2][r] = bb * c[r] + a * sn[r];
        }
      }
    }
  }
  if (seg == 1) {
#pragma unroll
    for (int ih = 0; ih < 2; ++ih) {
      float* kp = (float*)(ws + OFF_KPART) + ((size_t)(tm * 4 + wm * 2 + ih) * 4 + hd) * 128;
#pragma unroll
      for (int j = 0; j < 4; ++j)
#pragma unroll
        for (int r = 0; r < 4; ++r) {
          float sm = acc[ih * 4][j][r] + acc[ih * 4 + 1][j][r] + acc[ih * 4 + 2][j][r] + acc[ih * 4 + 3][j][r];
          sm = rowsum_f(sm);
          if (li == 0) kp[NCOL(j) + r] = sm;
        }
    }
  }
  if (seg == 4) {
#pragma unroll
    for (int i = 0; i < MI; ++i)
#pragma unroll
      for (int j = 0; j < 4; ++j) acc[i][j] *= 0.08838834764831843f;
  }
  if (seg != 6) {
    bf16_t* dst = R + (seg == 0 ? R_MQ : seg == 1 ? R_MK : seg == 3 ? R_RQ : R_RK) + (size_t)bh * 4096 * 128;
#pragma unroll
    for (int i = 0; i < MI; ++i)
#pragma unroll
      for (int j = 0; j < 4; ++j) {
        u32x2 v;
        v.x = pk_bf16(acc[i][j][0], acc[i][j][1]);
        v.y = pk_bf16(acc[i][j][2], acc[i][j][3]);
        *(u32x2*)(dst + (size_t)(s0 + MROW(i)) * 128 + NCOL(j)) = v;
      }
  }
  if (seg == 4) {
    bf16_t* dst = R + R_RKT + (size_t)bh * 128 * 4096;
    const float lg = LOG2G[hd];
#pragma unroll
    for (int i = 0; i < MI; ++i) {
      const int s = s0 + MROW(i);
      const float z = exp2f((float)(127 - (s & 127)) * lg);
#pragma unroll
      for (int j = 0; j < 4; ++j)
#pragma unroll
        for (int r = 0; r < 4; ++r) dst[(size_t)(NCOL(j) + r) * 4096 + s] = f2bf(acc[i][j][r] * z);
    }
  }
  if (seg == 6) {
    bf16_t* dst = R + R_RG;
#pragma unroll
    for (int i = 0; i < MI; ++i)
#pragma unroll
      for (int j = 0; j < 4; ++j) {
        u32x2 v;
        v.x = pk_bf16(acc[i][j][0], acc[i][j][1]);
        v.y = pk_bf16(acc[i][j][2], acc[i][j][3]);
        *(u32x2*)(dst + (size_t)(t0 + MROW(i)) * 512 + hd * 128 + NCOL(j)) = v;
      }
  }
}

__device__ void tr_cvt_tiles(const float* src, bf16_t* dst, int K, int N, int nl, char* smem) {
  float(*t)[65] = (float(*)[65])smem;
  const int tk = K >> 6, tnn = N >> 6, per = tk * tnn, total = per * nl;
  const int tid = threadIdx.x;
  for (int it = blockIdx.x; it < total; it += gridDim.x) {
    const int l = it / per, rem = it % per, kt = rem / tnn, nt = rem % tnn;
    const float* s = src + (size_t)l * K * N + (size_t)kt * 64 * N + nt * 64;
    bf16_t* d = dst + (size_t)l * K * N + (size_t)nt * 64 * K + kt * 64;
    __syncthreads();
#pragma unroll
    for (int i = 0; i < 16; ++i) {
      const int e = tid + i * 256, r = e >> 6, c = e & 63;
      t[r][c] = s[(size_t)r * N + c];
    }
    __syncthreads();
#pragma unroll
    for (int i = 0; i < 16; ++i) {
      const int e = tid + i * 256, n = e >> 6, k = e & 63;
      d[(size_t)n * K + k] = f2bf(t[k][n]);
    }
  }
}
__device__ void cvt_straight(const float* src, bf16_t* dst, size_t n) {
  const size_t n4 = n >> 2;
  for (size_t i = (size_t)blockIdx.x * 256 + threadIdx.x; i < n4; i += (size_t)gridDim.x * 256) {
    const f32x4 v = ((const f32x4*)src)[i];
    u32x2 o;
    o.x = pk_bf16(v.x, v.y);
    o.y = pk_bf16(v.z, v.w);
    ((u32x2*)dst)[i] = o;
  }
}
__device__ void rmsnorm_rows(const float* src, const float* gw, bf16_t* dst, float* copy, unsigned char* dst8 = nullptr) {
  const int tid_ = otid(); const int lane = tid_ & 63, w = tid_ >> 6;
  f32x4 gg[4];
#pragma unroll
  for (int k = 0; k < 4; ++k) gg[k] = ((const f32x4*)gw)[lane + 64 * k];
  const int stride = gridDim.x * 4;
  for (int row0 = blockIdx.x * 4 + w; row0 < T_TOK; row0 += stride * 4) {
    f32x4 v[4][4];
#pragma unroll
    for (int rr = 0; rr < 4; ++rr) {
      const int row = row0 + rr * stride;
      if (row < T_TOK) {
        const f32x4* sp = (const f32x4*)(src + (size_t)row * 1024);
#pragma unroll
        for (int k = 0; k < 4; ++k) v[rr][k] = sp[lane + 64 * k];
      }
    }
#pragma unroll
    for (int rr = 0; rr < 4; ++rr) {
      const int row = row0 + rr * stride;
      if (row < T_TOK) {
        float ss = 0.f;
#pragma unroll
        for (int k = 0; k < 4; ++k) ss += v[rr][k].x * v[rr][k].x + v[rr][k].y * v[rr][k].y + v[rr][k].z * v[rr][k].z + v[rr][k].w * v[rr][k].w;
        ss = wavesum_f(ss);
        const float rs = rsqrtf(ss * (1.f / 1024.f) + 1e-6f);
#pragma unroll
        for (int k = 0; k < 4; ++k) {
          const f32x4 y = v[rr][k] * rs * gg[k];
          u32x2 o;
          o.x = pk_bf16(y.x, y.y);
          o.y = pk_bf16(y.z, y.w);
          ((u32x2*)(dst + (size_t)row * 1024))[lane + 64 * k] = o;
          if (dst8) {
            int wd = __builtin_amdgcn_cvt_pk_fp8_f32(y.x, y.y, 0, false);
            wd = __builtin_amdgcn_cvt_pk_fp8_f32(y.z, y.w, wd, true);
            ((int*)(dst8 + (size_t)row * 1024))[lane + 64 * k] = wd;
          }
          if (copy) ((f32x4*)(copy + (size_t)row * 1024))[lane + 64 * k] = v[rr][k];
        }
      }
    }
  }
}

__device__ void moba_item(const P& p, int bh, int qt, char* smem) {
  char* ws = opaque(p.ws);
  const bf16_t* R = (const bf16_t*)(ws + OFF_R);
  const bf16_t* Q = R + R_MQ + (size_t)bh * 4096 * 128;
  const bf16_t* Kp = R + R_MK + (size_t)bh * 4096 * 128;
  const bf16_t* VT = R + R_MVT + (size_t)bh * 128 * 4096;
  const int b = bh >> 2, hd = bh & 3;
  const int qblk = qt >> 2, qin = qt & 3;
  const int q0 = qt * 64;
  const int tid = otid(), lane = tid & 63, w = tid >> 6, li = lane & 15, g = lane >> 4;
  char* sK = smem;
  char* sV = smem + 16384;
  float* sGate = (float*)(smem + 32768);
  unsigned* sMask = (unsigned*)(smem + 36864);
  float* sKm = (float*)(smem + 37120);
  __syncthreads();
  {
    const float* kp = (const float*)(ws + OFF_KPART);
    for (int e = tid; e < qblk * 128; e += 256) {
      const int n = e >> 7, d = e & 127;
      float sm = 0.f;
#pragma unroll
      for (int x4 = 0; x4 < 4; ++x4) sm += kp[((size_t)(b * 64 + n * 4 + x4) * 4 + hd) * 128 + d];
      sKm[n * 132 + d] = sm * (1.f / 256.f);
    }
  }
  __syncthreads();
  {
    const int q = tid >> 2, nb = (tid & 3) * 4;
    const u32x4* qp = (const u32x4*)(Q + (size_t)(q0 + q) * 128);
    float gsum[4] = {0.f, 0.f, 0.f, 0.f};
    u32x4 qrow[16];
#pragma unroll
    for (int c = 0; c < 16; ++c) qrow[c] = qp[c];
#pragma unroll
    for (int c = 0; c < 16; ++c) {
      const u32x4 u = qrow[c];
      const float qv[8] = {bf_lo(u.x), bf_hi(u.x), bf_lo(u.y), bf_hi(u.y), bf_lo(u.z), bf_hi(u.z), bf_lo(u.w), bf_hi(u.w)};
#pragma unroll
      for (int nn = 0; nn < 4; ++nn) {
        if (nb + nn < qblk) {
          const float* km = sKm + (nb + nn) * 132 + c * 8;
#pragma unroll
          for (int e = 0; e < 8; ++e) gsum[nn] += qv[e] * km[e];
        }
      }
    }
#pragma unroll
    for (int nn = 0; nn < 4; ++nn) sGate[q * 16 + nb + nn] = gsum[nn];
  }
  __syncthreads();
  if (tid < 64) {
    unsigned m = 0;
    for (int n = 0; n < qblk; ++n) {
      const float gn = sGate[tid * 16 + n];
      int rank = 0;
      for (int mm = 0; mm < qblk; ++mm) {
        const float gm = sGate[tid * 16 + mm];
        rank += (gm > gn || (gm == gn && mm < n)) ? 1 : 0;
      }
      if (rank < 3) m |= 1u << n;
    }
    sMask[tid] = m;
  }
  __syncthreads();
  const unsigned mymask = sMask[w * 16 + li];
  const int qpos = q0 + w * 16 + li;
  bf16x8 qf[4];
#pragma unroll
  for (int kk = 0; kk < 4; ++kk) qf[kk] = *(const bf16x8*)(Q + (size_t)qpos * 128 + (kk * 4 + g) * 8);
  f32x4 oacc[8];
#pragma unroll
  for (int d = 0; d < 8; ++d) oacc[d] = (f32x4){0.f, 0.f, 0.f, 0.f};
  float mrun = -INFINITY, lrun = 0.f;
  const int ntiles = qblk * 4 + qin + 1;
  const int kr = tid >> 4, kc = tid & 15;
  const int vr = tid >> 3, vc = tid & 7;
  u32x4 rkA[4], rvA[4], rkB[4], rvB[4];
#pragma unroll
  for (int i = 0; i < 4; ++i) {
    rkA[i] = *(const u32x4*)(Kp + (size_t)(kr + 16 * i) * 128 + kc * 8);
    rvA[i] = *(const u32x4*)(VT + (size_t)(vr + 32 * i) * 4096 + vc * 8);
  }
  if (ntiles > 1) {
#pragma unroll
    for (int i = 0; i < 4; ++i) {
      rkB[i] = *(const u32x4*)(Kp + (size_t)(64 + kr + 16 * i) * 128 + kc * 8);
      rvB[i] = *(const u32x4*)(VT + (size_t)(vr + 32 * i) * 4096 + 64 + vc * 8);
    }
  }
  const float SC = 0.12751743082459868f;
  auto step = [&](const int tt, u32x4 (&rk)[4], u32x4 (&rv)[4]) __attribute__((always_inline)) {
    __syncthreads();
#pragma unroll
    for (int i = 0; i < 4; ++i) {
      const int row = kr + 16 * i;
      const int f = ((row >> 3) & 3) * 4 + (row & 3);
      *(u32x4*)(sK + row * 256 + ((kc ^ f) << 4)) = rk[i];
      const int vrow = vr + 32 * i;
      *(u32x4*)(sV + vrow * 128 + ((vc ^ (vrow & 7)) << 4)) = rv[i];
    }
    __syncthreads();
    if (tt + 2 < ntiles) {
      const int k1 = (tt + 2) * 64;
#pragma unroll
      for (int i = 0; i < 4; ++i) {
        rk[i] = *(const u32x4*)(Kp + (size_t)(k1 + kr + 16 * i) * 128 + kc * 8);
        rv[i] = *(const u32x4*)(VT + (size_t)(vr + 32 * i) * 4096 + k1 + vc * 8);
      }
    }
    const int blk = tt >> 2;
    const bool own = (blk == qblk);
    const bool rowvalid = own || ((mymask >> blk) & 1u);
    if (__any(rowvalid)) {
      const int key0 = tt * 64;
      f32x4 sacc[2][2];
#pragma unroll
      for (int st = 0; st < 2; ++st)
#pragma unroll
        for (int kt = 0; kt < 2; ++kt) {
          sacc[st][kt] = (f32x4){0.f, 0.f, 0.f, 0.f};
          const int row = 32 * st + 8 * (li >> 2) + 4 * kt + (li & 3);
#pragma unroll
          for (int kk = 0; kk < 4; ++kk) {
            const bf16x8 kf = *(const bf16x8*)(sK + row * 256 + (((kk * 4 + g) ^ li) << 4));
            sacc[st][kt] = __builtin_amdgcn_mfma_f32_16x16x32_bf16(kf, qf[kk], sacc[st][kt], 0, 0, 0);
          }
        }
      const bool diag = (tt == ntiles - 1);
      float mx = -INFINITY;
      if (diag || !__all(rowvalid)) {
#pragma unroll
        for (int st = 0; st < 2; ++st)
#pragma unroll
          for (int kt = 0; kt < 2; ++kt)
#pragma unroll
            for (int r = 0; r < 4; ++r) {
              const int key = key0 + 32 * st + 8 * g + 4 * kt + r;
              bool ok = rowvalid && (!diag || key <= qpos);
              const float sv = ok ? sacc[st][kt][r] * SC : -INFINITY;
              sacc[st][kt][r] = sv;
              mx = fmaxf(mx, sv);
            }
      } else {
#pragma unroll
        for (int st = 0; st < 2; ++st)
#pragma unroll
          for (int kt = 0; kt < 2; ++kt) {
            sacc[st][kt] *= SC;
            mx = fmaxf(mx, fmaxf(fmaxf(sacc[st][kt][0], sacc[st][kt][1]), fmaxf(sacc[st][kt][2], sacc[st][kt][3])));
          }
      }
      mx = fmaxf(mx, __shfl_xor(mx, 16));
      mx = fmaxf(mx, __shfl_xor(mx, 32));
      const float mnew = (mx > mrun + 6.f) ? mx : mrun;
      const float muse = (mnew == -INFINITY) ? 0.f : mnew;
      const bool resc = __any(mnew != mrun);
      const float alpha = __builtin_amdgcn_exp2f(mrun - muse);
      mrun = mnew;
      float ps = 0.f;
      bf16x8 pf[2];
#pragma unroll
      for (int st = 0; st < 2; ++st) {
        float pv[8];
#pragma unroll
        for (int kt = 0; kt < 2; ++kt)
#pragma unroll
          for (int r = 0; r < 4; ++r) {
            const float e = __builtin_amdgcn_exp2f(sacc[st][kt][r] - muse);
            pv[kt * 4 + r] = e;
            ps += e;
          }
        u32x4 u;
        u.x = pk_bf16(pv[0], pv[1]); u.y = pk_bf16(pv[2], pv[3]); u.z = pk_bf16(pv[4], pv[5]); u.w = pk_bf16(pv[6], pv[7]);
        pf[st] = *(bf16x8*)&u;
      }
      lrun = lrun * alpha + ps;
      if (resc) {
#pragma unroll
        for (int d = 0; d < 8; ++d) oacc[d] *= alpha;
      }
#pragma unroll
      for (int d = 0; d < 8; ++d) {
        const int row = d * 16 + li;
#pragma unroll
        for (int st = 0; st < 2; ++st) {
          const bf16x8 vf = *(const bf16x8*)(sV + row * 128 + (((st * 4 + g) ^ (li & 7)) << 4));
          oacc[d] = __builtin_amdgcn_mfma_f32_16x16x32_bf16(vf, pf[st], oacc[d], 0, 0, 0);
        }
      }
    }
    };
  for (int tt = 0; tt < ntiles; tt += 2) {
    step(tt, rkA, rvA);
    if (tt + 1 < ntiles) step(tt + 1, rkB, rvB);
  }
  lrun += __shfl_xor(lrun, 16);
  lrun += __shfl_xor(lrun, 32);
  const float inv = 1.f / lrun;
  bf16_t* ao = (bf16_t*)(ws + OFF_AO) + (size_t)(b * 4096 + qpos) * 1024 + hd * 128;
#pragma unroll
  for (int d = 0; d < 8; ++d) {
    u32x2 v;
    v.x = pk_bf16(oacc[d][0] * inv, oacc[d][1] * inv);
    v.y = pk_bf16(oacc[d][2] * inv, oacc[d][3] * inv);
    *(u32x2*)(ao + d * 16 + g * 4) = v;
  }
}

__device__ void ret_out_item(const P& p, int bh, int c) {
  char* ws = opaque(p.ws);
  const bf16_t* R = (const bf16_t*)(ws + OFF_R);
  const int b = bh >> 2, hd = bh & 3;
  const bf16_t* Q = R + R_RQ + ((size_t)bh * 4096 + c * 128) * 128;
  const bf16_t* Kp = R + R_RK + ((size_t)bh * 4096 + c * 128) * 128;
  const bf16_t* VT = R + R_RVT + (size_t)bh * 128 * 4096 + c * 128;
  const bf16_t* ST = (const bf16_t*)(ws + OFF_ST) + (size_t)(bh * 32 + c) * 16384;
  const int tid_ = otid(); const int lane = tid_ & 63, w = tid_ >> 6, li = lane & 15, g = lane >> 4;
  const float lg = LOG2G[hd];
  bf16x8 qf[2][4];
#pragma unroll
  for (int ns = 0; ns < 2; ++ns)
#pragma unroll
    for (int kk = 0; kk < 4; ++kk) qf[ns][kk] = *(const bf16x8*)(Q + (size_t)(32 * w + 16 * ns + li) * 128 + (kk * 4 + g) * 8);
  f32x4 acc[8][2];
#pragma unroll
  for (int es = 0; es < 8; ++es)
#pragma unroll
    for (int ns = 0; ns < 2; ++ns) acc[es][ns] = (f32x4){0.f, 0.f, 0.f, 0.f};
  if (c > 0) {
#pragma unroll
    for (int es = 0; es < 8; ++es)
#pragma unroll
      for (int kk = 0; kk < 4; ++kk) {
        const bf16x8 sf = *(const bf16x8*)(ST + (size_t)(es * 16 + li) * 128 + (kk * 4 + g) * 8);
#pragma unroll
        for (int ns = 0; ns < 2; ++ns) acc[es][ns] = __builtin_amdgcn_mfma_f32_16x16x32_bf16(sf, qf[ns][kk], acc[es][ns], 0, 0, 0);
      }
#pragma unroll
    for (int ns = 0; ns < 2; ++ns) {
      const float xi = exp2f((float)(32 * w + 16 * ns + li + 1) * lg);
#pragma unroll
      for (int es = 0; es < 8; ++es) {
        acc[es][ns][0] *= xi; acc[es][ns][1] *= xi; acc[es][ns][2] *= xi; acc[es][ns][3] *= xi;
      }
    }
  }
  for (int ms = 0; ms <= w; ++ms) {
    f32x4 sacc[2][2];
#pragma unroll
    for (int kt = 0; kt < 2; ++kt) {
      const int row = 32 * ms + 8 * (li >> 2) + 4 * kt + (li & 3);
#pragma unroll
      for (int ns = 0; ns < 2; ++ns) sacc[kt][ns] = (f32x4){0.f, 0.f, 0.f, 0.f};
#pragma unroll
      for (int kk = 0; kk < 4; ++kk) {
        const bf16x8 kf = *(const bf16x8*)(Kp + (size_t)row * 128 + (kk * 4 + g) * 8);
#pragma unroll
        for (int ns = 0; ns < 2; ++ns) sacc[kt][ns] = __builtin_amdgcn_mfma_f32_16x16x32_bf16(kf, qf[ns][kk], sacc[kt][ns], 0, 0, 0);
      }
    }
    bf16x8 pf[2];
#pragma unroll
    for (int ns = 0; ns < 2; ++ns) {
      const int n = 32 * w + 16 * ns + li;
      float pv[8];
#pragma unroll
      for (int kt = 0; kt < 2; ++kt)
#pragma unroll
        for (int r = 0; r < 4; ++r) {
          const int m = 32 * ms + 8 * g + 4 * kt + r;
          const float dec = (n >= m) ? exp2f((float)(n - m) * lg) : 0.f;
          pv[kt * 4 + r] = sacc[kt][ns][r] * dec;
        }
      u32x4 u;
      u.x = pk_bf16(pv[0], pv[1]); u.y = pk_bf16(pv[2], pv[3]); u.z = pk_bf16(pv[4], pv[5]); u.w = pk_bf16(pv[6], pv[7]);
      pf[ns] = *(bf16x8*)&u;
    }
#pragma unroll
    for (int es = 0; es < 8; ++es) {
      const bf16x8 vf = *(const bf16x8*)(VT + (size_t)(es * 16 + li) * 4096 + 32 * ms + 8 * g);
#pragma unroll
      for (int ns = 0; ns < 2; ++ns) acc[es][ns] = __builtin_amdgcn_mfma_f32_16x16x32_bf16(vf, pf[ns], acc[es][ns], 0, 0, 0);
    }
  }
  const bf16_t* RG = R + R_RG;
  bf16_t* ao = (bf16_t*)(ws + OFF_AO);
#pragma unroll
  for (int ns = 0; ns < 2; ++ns) {
    float ss = 0.f;
#pragma unroll
    for (int es = 0; es < 8; ++es)
#pragma unroll
      for (int r = 0; r < 4; ++r) ss += acc[es][ns][r] * acc[es][ns][r];
    ss += __shfl_xor(ss, 16);
    ss += __shfl_xor(ss, 32);
    const float rs = rsqrtf(ss * (1.f / 128.f) + 1e-6f);
    const size_t t = (size_t)b * 4096 + c * 128 + 32 * w + 16 * ns + li;
#pragma unroll
    for (int es = 0; es < 8; ++es) {
      const int e = es * 16 + g * 4;
      const u32x2 gu = *(const u32x2*)(RG + t * 512 + hd * 128 + e);
      const float gv[4] = {bf_lo(gu.x), bf_hi(gu.x), bf_lo(gu.y), bf_hi(gu.y)};
      float o[4];
#pragma unroll
      for (int r = 0; r < 4; ++r) {
        const float sg = gv[r] / (1.f + __expf(-gv[r]));
        o[r] = acc[es][ns][r] * rs * sg;
      }
      u32x2 v;
      v.x = pk_bf16(o[0], o[1]);
      v.y = pk_bf16(o[2], o[3]);
      *(u32x2*)(ao + t * 1024 + 512 + hd * 128 + e) = v;
    }
  }
}

#define CSWAP(a, b) { unsigned _h = (a) > (b) ? (a) : (b); unsigned _l = (a) > (b) ? (b) : (a); (a) = _h; (b) = _l; }

__device__ void peer_token(const P& p, int layer, int tok, bool dry, char* smem) {
  char* ws = opaque(p.ws);
  const int tid_ = otid(); const int lane = tid_ & 63, li = lane & 15, rw = lane >> 4, rbase = lane & 48;
  const bf16_t* sc = (const bf16_t*)(ws + OFF_R + R_SC_BYTES) + (size_t)tok * 2048;
  unsigned res[4];
#pragma unroll
  for (int pp = 0; pp < 4; ++pp) {
    const int head = 4 * (pp >> 1) + rw, half = pp & 1, hp = head * 2 + half;
    const u32x4 a0 = *(const u32x4*)(sc + hp * 128 + li * 8);
    unsigned k[8];
    const float vv[8] = {bf_lo(a0.x), bf_hi(a0.x), bf_lo(a0.y), bf_hi(a0.y), bf_lo(a0.z), bf_hi(a0.z), bf_lo(a0.w), bf_hi(a0.w)};
#pragma unroll
    for (int e = 0; e < 8; ++e) k[e] = (f_ord(vv[e]) & ~0x7Fu) | (unsigned)(127 - (li * 8 + e));
    CSWAP(k[0], k[1]) CSWAP(k[2], k[3]) CSWAP(k[4], k[5]) CSWAP(k[6], k[7])
    CSWAP(k[0], k[2]) CSWAP(k[1], k[3]) CSWAP(k[4], k[6]) CSWAP(k[5], k[7])
    CSWAP(k[1], k[2]) CSWAP(k[5], k[6])
    CSWAP(k[0], k[4]) CSWAP(k[1], k[5]) CSWAP(k[2], k[6]) CSWAP(k[3], k[7])
    CSWAP(k[2], k[4]) CSWAP(k[3], k[5])
    CSWAP(k[1], k[2]) CSWAP(k[3], k[4]) CSWAP(k[5], k[6])
    unsigned keep = 0;
#pragma unroll
    for (int rd = 0; rd < 16; ++rd) {
      const unsigned wk = rowmax_u(k[0]);
      if (li == rd) keep = wk;
      const bool win = (k[0] == wk);
      k[0] = win ? k[1] : k[0]; k[1] = win ? k[2] : k[1]; k[2] = win ? k[3] : k[2]; k[3] = win ? k[4] : k[3];
      k[4] = win ? k[5] : k[4]; k[5] = win ? k[6] : k[5]; k[6] = win ? k[7] : k[6]; k[7] = win ? 0u : k[7];
    }
    res[pp] = keep;
  }
  int eidx[2];
  float gate[2];
#pragma unroll
  for (int hp2 = 0; hp2 < 2; ++hp2) {
    const unsigned k1 = res[hp2 * 2], k2 = res[hp2 * 2 + 1];
    const float s1 = f_deord(k1 & ~0x7Fu), s2 = f_deord(k2 & ~0x7Fu);
    const int i1 = 127 - (int)(k1 & 0x7Fu), i2 = 127 - (int)(k2 & 0x7Fu);
    int ptr = 0;
    unsigned keep = 0;
    float s2p = __uint_as_float((unsigned)__builtin_amdgcn_ds_bpermute((rbase + 0) * 4, (int)__float_as_uint(s2)));
    unsigned hk = (f_ord(s1 + s2p) & ~0xFFu) | (unsigned)(255 - (li * 16 + 0));
#pragma unroll
    for (int rd = 0; rd < 16; ++rd) {
      const unsigned wk = rowmax_u(hk);
      if (li == rd) keep = wk;
      const bool win = (hk == wk);
      ptr += win ? 1 : 0;
      const int pcl = ptr < 15 ? ptr : 15;
      s2p = __uint_as_float((unsigned)__builtin_amdgcn_ds_bpermute((rbase + pcl) * 4, (int)__float_as_uint(s2)));
      const unsigned nk = (f_ord(s1 + s2p) & ~0xFFu) | (unsigned)(255 - (li * 16 + pcl));
      hk = win ? (ptr < 16 ? nk : 0u) : hk;
    }
    const float ts = f_deord(keep & ~0xFFu);
    const int idx8 = 255 - (int)(keep & 0xFFu);
    const int a = idx8 >> 4, bq = idx8 & 15;
    const int e1 = __builtin_amdgcn_ds_bpermute((rbase + a) * 4, i1);
    const int e2 = __builtin_amdgcn_ds_bpermute((rbase + bq) * 4, i2);
    eidx[hp2] = e1 * 128 + e2;
    const float tmax = f_deord(rowmax_u(keep) & ~0xFFu);
    const float ex = __expf(ts - tmax);
    const float sm = rowsum_f(ex);
    gate[hp2] = ex / sm;
  }
  const bf16_t* xn = (const bf16_t*)(ws + OFF_XN) + (size_t)tok * 1024;
  i32x8 tq[8];
#pragma unroll
  for (int s8 = 0; s8 < 8; ++s8) {
#pragma unroll
    for (int c4 = 0; c4 < 4; ++c4) {
      const u32x4 u = *(const u32x4*)(xn + s8 * 128 + (c4 >> 1) * 64 + rw * 16 + (c4 & 1) * 8);
      int w0 = __builtin_amdgcn_cvt_pk_fp8_f32(bf_lo(u.x), bf_hi(u.x), 0, false);
      w0 = __builtin_amdgcn_cvt_pk_fp8_f32(bf_lo(u.y), bf_hi(u.y), w0, true);
      int w1 = __builtin_amdgcn_cvt_pk_fp8_f32(bf_lo(u.z), bf_hi(u.z), 0, false);
      w1 = __builtin_amdgcn_cvt_pk_fp8_f32(bf_lo(u.w), bf_hi(u.w), w1, true);
      tq[s8][c4 * 2] = w0;
      tq[s8][c4 * 2 + 1] = w1;
    }
  }
  const unsigned char* U4 = (const unsigned char*)(ws + OFF_U) + (size_t)layer * 16384 * 512;
  const unsigned char* V4 = (const unsigned char*)(ws + OFF_U) + (size_t)(4 + layer) * 16384 * 512;
  const float* SU = (const float*)(ws + OFF_V) + (size_t)layer * 16384;
  const float* SV = (const float*)(ws + OFF_V) + (size_t)(4 + layer) * 16384;
  char* lw = smem + (tid_ >> 6) * 8704;
  float wreg[2];
#pragma unroll
  for (int h2 = 0; h2 < 2; ++h2) {
    const float su = SU[eidx[h2]], sv = SV[eidx[h2]];
    float hreg = 0.f;
    for (int b2 = 0; b2 < 2; ++b2) {
      u32x2 uu[32];
#pragma unroll
      for (int q = 0; q < 32; ++q) {
        const int e = __builtin_amdgcn_readlane(eidx[h2], b2 * 32 + q);
        uu[q] = ((const u32x2*)(U4 + (size_t)e * 512))[lane];
      }
#pragma unroll
      for (int hh = 0; hh < 2; ++hh) {
#pragma unroll
        for (int q = 0; q < 16; ++q) *(u32x2*)(lw + q * 544 + lane * 8) = uu[hh * 16 + q];
        f32x4 acc = {0.f, 0.f, 0.f, 0.f};
#pragma unroll
        for (int s8 = 0; s8 < 8; ++s8) {
          const u32x4 a = *(const u32x4*)(lw + li * 544 + s8 * 64 + rw * 16);
          const i32x8 av = {(int)a.x, (int)a.y, (int)a.z, (int)a.w, 0, 0, 0, 0};
          acc = __builtin_amdgcn_mfma_scale_f32_16x16x128_f8f6f4(av, tq[s8], acc, 4, 0, 0, 0x7f7f7f7f, 0, 0x7f7f7f7f);
        }
        const int lr2 = li & 3;
        const float sel = lr2 == 0 ? acc[0] : lr2 == 1 ? acc[1] : lr2 == 2 ? acc[2] : acc[3];
        const float val = __uint_as_float((unsigned)__builtin_amdgcn_ds_bpermute(((li >> 2) * 16 + li) * 4, (int)__float_as_uint(sel)));
        hreg = (rw == b2 * 2 + hh) ? val : hreg;
      }
    }
    const float hid = hreg * su;
    const float ge = 0.5f * hid * (1.f + erff(hid * 0.70710678118654752f));
    wreg[h2] = gate[h2] * ge * sv;
  }
  f32x2 oa2[8];
#pragma unroll
  for (int e = 0; e < 8; ++e) oa2[e] = (f32x2){0.f, 0.f};
#pragma unroll
  for (int h2 = 0; h2 < 2; ++h2) {
    for (int jb = 0; jb < 64; jb += 32) {
      u32x2 vv[32];
#pragma unroll
      for (int q = 0; q < 32; ++q) {
        const int e = __builtin_amdgcn_readlane(eidx[h2], jb + q);
        vv[q] = ((const u32x2*)(V4 + (size_t)e * 512))[lane];
      }
#pragma unroll
      for (int q = 0; q < 32; ++q) {
        const float wq = rdlane_f(wreg[h2], jb + q);
        const f32x2 w2 = {wq, wq};
#pragma unroll
        for (int k = 0; k < 2; ++k) {
          oa2[4 * k + 0] += w2 * __builtin_amdgcn_cvt_scalef32_pk_f32_fp4(vv[q][k], 1.0f, 0);
          oa2[4 * k + 1] += w2 * __builtin_amdgcn_cvt_scalef32_pk_f32_fp4(vv[q][k], 1.0f, 1);
          oa2[4 * k + 2] += w2 * __builtin_amdgcn_cvt_scalef32_pk_f32_fp4(vv[q][k], 1.0f, 2);
          oa2[4 * k + 3] += w2 * __builtin_amdgcn_cvt_scalef32_pk_f32_fp4(vv[q][k], 1.0f, 3);
        }
      }
    }
  }
  float* hrow = (float*)(ws + OFF_H) + (size_t)tok * 1024;
  float hv[16];
#pragma unroll
  for (int k = 0; k < 4; ++k) {
    const f32x4 h4 = ((const f32x4*)hrow)[lane * 4 + k];
    hv[4 * k] = h4.x; hv[4 * k + 1] = h4.y; hv[4 * k + 2] = h4.z; hv[4 * k + 3] = h4.w;
  }
  float ss = 0.f;
#pragma unroll
  for (int e = 0; e < 8; ++e) {
    hv[2 * e] += oa2[e].x;
    hv[2 * e + 1] += oa2[e].y;
  }
#pragma unroll
  for (int e = 0; e < 16; ++e) ss += hv[e] * hv[e];
  ss = wavesum_f(ss);
  if (dry) { if (lane == 0) ((float*)(ws + OFF_S))[tok] = ss; return; }
  const float rs = rsqrtf(ss * (1.f / 1024.f) + 1e-6f);
  const float* gw = (layer < 3) ? (p.norm_mix + (size_t)(layer + 1) * 1024) : p.final_norm;
  float y[16];
#pragma unroll
  for (int k = 0; k < 4; ++k) {
    const f32x4 g4 = ((const f32x4*)gw)[lane * 4 + k];
    y[4 * k] = hv[4 * k] * rs * g4.x; y[4 * k + 1] = hv[4 * k + 1] * rs * g4.y;
    y[4 * k + 2] = hv[4 * k + 2] * rs * g4.z; y[4 * k + 3] = hv[4 * k + 3] * rs * g4.w;
  }
  if (layer < 3) {
#pragma unroll
    for (int k = 0; k < 4; ++k) ((f32x4*)hrow)[lane * 4 + k] = MAKEF4(hv[4 * k], hv[4 * k + 1], hv[4 * k + 2], hv[4 * k + 3]);
    bf16_t* xo = (bf16_t*)(ws + OFF_XN) + (size_t)tok * 1024;
    u32x4 o0, o1;
    o0.x = pk_bf16(y[0], y[1]); o0.y = pk_bf16(y[2], y[3]); o0.z = pk_bf16(y[4], y[5]); o0.w = pk_bf16(y[6], y[7]);
    o1.x = pk_bf16(y[8], y[9]); o1.y = pk_bf16(y[10], y[11]); o1.z = pk_bf16(y[12], y[13]); o1.w = pk_bf16(y[14], y[15]);
    ((u32x4*)xo)[lane * 2] = o0;
    ((u32x4*)xo)[lane * 2 + 1] = o1;
  } else {
    float* orow = p.out + (size_t)tok * 1024;
#pragma unroll
    for (int k = 0; k < 4; ++k) ((f32x4*)orow)[lane * 4 + k] = MAKEF4(y[4 * k], y[4 * k + 1], y[4 * k + 2], y[4 * k + 3]);
  }
}

__device__ void quant_rows(const float* src, unsigned char* dst, float* scales, int row_begin, int nrows) {
  const int tid_ = otid();
  const int lane = tid_ & 63, w = tid_ >> 6;
  for (int row = row_begin + blockIdx.x * 4 + w; row < nrows; row += gridDim.x * 4) {
    const f32x4* sp = (const f32x4*)(src + (size_t)row * 1024) + lane * 4;
    f32x4 v[4];
    float am = 0.f;
#pragma unroll
    for (int k = 0; k < 4; ++k) {
      v[k] = sp[k];
      am = fmaxf(am, fmaxf(fmaxf(fabsf(v[k].x), fabsf(v[k].y)), fmaxf(fabsf(v[k].z), fabsf(v[k].w))));
    }
    am = fmaxf(am, __shfl_xor(am, 1)); am = fmaxf(am, __shfl_xor(am, 2)); am = fmaxf(am, __shfl_xor(am, 4));
    am = fmaxf(am, __shfl_xor(am, 8)); am = fmaxf(am, __shfl_xor(am, 16)); am = fmaxf(am, __shfl_xor(am, 32));
    const float sc = am > 0.f ? 6.f / am : 1.f;
    u32x2 o;
#pragma unroll
    for (int k = 0; k < 2; ++k) {
      unsigned wd = 0u;
      wd = __builtin_amdgcn_cvt_scalef32_pk_fp4_f32(wd, v[2 * k].x * sc, v[2 * k].y * sc, 1.0f, 0);
      wd = __builtin_amdgcn_cvt_scalef32_pk_fp4_f32(wd, v[2 * k].z * sc, v[2 * k].w * sc, 1.0f, 1);
      wd = __builtin_amdgcn_cvt_scalef32_pk_fp4_f32(wd, v[2 * k + 1].x * sc, v[2 * k + 1].y * sc, 1.0f, 2);
      wd = __builtin_amdgcn_cvt_scalef32_pk_fp4_f32(wd, v[2 * k + 1].z * sc, v[2 * k + 1].w * sc, 1.0f, 3);
      o[k] = wd;
    }
    ((u32x2*)(dst + (size_t)row * 512))[lane] = o;
    if (lane == 0) scales[row] = am > 0.f ? am * (1.f / 6.f) : 1.f;
  }
}

__global__ void __launch_bounds__(256, 2) fwd_kernel(P p) {
  __shared__ __attribute__((aligned(16))) char smem[65536];
  cg::grid_group grid = cg::this_grid();
  char* ws = opaque(p.ws);
  XB xb;
  xb.bar = (unsigned*)(ws + OFF_BAR);
  xb.x = (unsigned)__builtin_amdgcn_s_getreg((3 << 11) | 20) & 0xFu;
  xb.nloc = 0u; xb.nx = 0u;
  if (threadIdx.x == 0) (void)xb_add(&xb.bar[XB_XCNT(xb.x)], 1u);
  const int tid = threadIdx.x;
  const int G = gridDim.x;

  if (STOP == 0) { grid.sync(); return; }
  tr_cvt_tiles(p.even_w_in, (bf16_t*)(ws + OFF_WEIN), 1024, 3584, 2, smem);
  tr_cvt_tiles(p.even_w_out, (bf16_t*)(ws + OFF_WEOUT), 1024, 1024, 2, smem);
  tr_cvt_tiles(p.odd_w_in, (bf16_t*)(ws + OFF_WOIN), 1024, 3072, 2, smem);
  tr_cvt_tiles(p.odd_w_out, (bf16_t*)(ws + OFF_WOOUT), 1024, 1024, 2, smem);
  cvt_straight(p.peer_w_q, (bf16_t*)(ws + OFF_AO), 4ull * 1024 * 2048);
  if (STOP == -1) { grid.sync(); return; }
  cvt_straight(p.peer_sub_keys, (bf16_t*)(ws + OFF_SUBK), 4ull * 8 * 2 * 128 * 128);
  quant_rows(p.peer_u, (unsigned char*)(ws + OFF_U), (float*)(ws + OFF_V), 0, 16384);
  quant_rows(p.peer_v, (unsigned char*)(ws + OFF_U) + 4ull * 16384 * 512, (float*)(ws + OFF_V) + 65536, 0, 16384);
  if (STOP == -2) { grid.sync(); return; }
  {
    float* ctab = (float*)(ws + OFF_COS);
    float* stab = (float*)(ws + OFF_SIN);
    for (int i = blockIdx.x * 256 + tid; i < 4096 * 64; i += G * 256) {
      const int s = i >> 6, d = i & 63;
      const float inv = (float)exp2(-(double)d * (13.287712379549449 / 64.0));
      const float ang = (float)s * inv;
      const double ad = (double)ang;
      const double kq = rint(ad * 0.15915494309189535);
      const float rr = (float)(ad - kq * 6.283185307179586);
      ctab[i] = __cosf(rr);
      stab[i] = __sinf(rr);
    }
  }
  if (STOP == -3) { grid.sync(); return; }
  rmsnorm_rows(p.x, p.norm_mix, (bf16_t*)(ws + OFF_XN), (float*)(ws + OFF_H));
  if (p.out == nullptr) grid.sync();
  gbar(xb);
  if (STOP == 1) return;

  for (int layer = 0; layer < 4; ++layer) {
    const int li2 = layer >> 1;
    ws = opaque(p.ws);
    const int tid = otid();
    const bf16_t* XN = (const bf16_t*)(ws + OFF_XN);
    float* H = (float*)(ws + OFF_H);
    if ((layer & 1) == 0) {
      for (int rep = 0; rep < REP_A; ++rep)
      for (int it = blockIdx.x; it < 64 * 28; it += G) even_in_tile(p, li2, (it & 7) * 8 + (it >> 3) / 28, (it >> 3) % 28, smem);
      if (layer == 0) {
        for (int it = blockIdx.x; it < 512; it += G) {
          const int lf = it >> 7, hp = (it >> 3) & 15, kc = it & 7;
          gemm_tile_fp8out<4>((const bf16_t*)(ws + OFF_SUBK) + ((size_t)lf * 16 + hp) * 16384, 128,
                              (const bf16_t*)(ws + OFF_AO) + (size_t)lf * 1024 * 2048 + (size_t)(kc * 128) * 2048 + hp * 128, 2048, 128,
                              (unsigned char*)(ws + OFF_WPQ) + ((size_t)lf * 2048 + hp * 128) * 1024 + kc * 128, 1024, 256.f, smem);
        }
      }
      gbar(xb);
      if (STOP == 2) return;
      const int qb = (layer == 0) ? 16384 : 49152, qe = (layer == 0) ? 49152 : 65536;
      if ((blockIdx.x & 256) == 0) {
        quant_rows(p.peer_u, (unsigned char*)(ws + OFF_U), (float*)(ws + OFF_V), qb, qe);
        quant_rows(p.peer_v, (unsigned char*)(ws + OFF_U) + 4ull * 16384 * 512, (float*)(ws + OFF_V) + 65536, qb, qe);
      }
      for (int rep = 0; rep < REP_B1; ++rep)
      for (int it = blockIdx.x; it < 1024 + 512; it += G) {
        if (it < 1024) {
          const int x = it >> 4, bh = it & 15;
          const int qt = (x < 32) ? (63 - x) : (x - 32);
          moba_item(p, bh, qt, smem);
        } else {
          const int idx = it - 1024, bh = idx >> 5, c = idx & 31;
          const bf16_t* Rb = (const bf16_t*)(ws + OFF_R);
          gemm_tile_f32<false, 4>(Rb + R_RVT + (size_t)bh * 128 * 4096 + c * 128, 4096,
                               Rb + R_RKT + (size_t)bh * 128 * 4096 + c * 128, 4096, 128,
                               (float*)(ws + OFF_S) + (size_t)idx * 16384, 128, smem);
        }
      }
      if ((blockIdx.x & 256) != 0) {
        quant_rows(p.peer_u, (unsigned char*)(ws + OFF_U), (float*)(ws + OFF_V), qb, qe);
        quant_rows(p.peer_v, (unsigned char*)(ws + OFF_U) + 4ull * 16384 * 512, (float*)(ws + OFF_V) + 65536, qb, qe);
      }
      gbar(xb);
      if (STOP == 3) return;
      {
        const float* S = (const float*)(ws + OFF_S);
        bf16_t* ST = (bf16_t*)(ws + OFF_ST);
        for (int i = blockIdx.x * 256 + tid; i < 16 * 16384 / 4; i += G * 256) {
          const int bh = i >> 12, off = (i & 4095) * 4;
          const float gc = exp2f(128.f * LOG2G[bh & 3]);
          f32x4 st = {0.f, 0.f, 0.f, 0.f};
          const float* Sp = S + (size_t)(bh * 32) * 16384 + off;
          bf16_t* Tp = ST + (size_t)(bh * 32) * 16384 + off;
          for (int c0 = 0; c0 < 32; c0 += 8) {
            f32x4 a[8];
#pragma unroll
            for (int c = 0; c < 8; ++c) a[c] = *(const f32x4*)(Sp + (size_t)(c0 + c) * 16384);
#pragma unroll
            for (int c = 0; c < 8; ++c) {
              u32x2 o;
              o.x = pk_bf16(st[0], st[1]); o.y = pk_bf16(st[2], st[3]);
              *(u32x2*)(Tp + (size_t)(c0 + c) * 16384) = o;
              st = st * gc + a[c];
            }
          }
        }
      }
      gbar(xb);
      if (STOP == 4) return;
      for (int rep = 0; rep < REP_B3; ++rep)
      for (int it = blockIdx.x; it < 512; it += G) ret_out_item(p, it >> 5, it & 31);
      gbar(xb);
      if (STOP == 5) return;
      for (int it = blockIdx.x; it < 64 * 8; it += G) {
        const int tm = (it & 7) * 8 + ((it >> 3) >> 3), tn = (it >> 3) & 7;
        gemm_tile_f32<true, 8>((const bf16_t*)(ws + OFF_AO) + (size_t)tm * 256 * 1024, 1024,
                            (const bf16_t*)(ws + OFF_WEOUT) + ((size_t)li2 * 1024 + tn * 128) * 1024, 1024, 1024,
                            H + (size_t)tm * 256 * 1024 + tn * 128, 1024, smem);
      }
      gbar(xb);
      if (STOP == 6) return;
    } else {
      bf16_t* PR = (bf16_t*)(ws + OFF_R);
      for (int it = blockIdx.x; it < 64 * 24; it += G) {
        const int tm = (it & 7) * 8 + (it >> 3) / 24, tn = (it >> 3) % 24;
        gemm_tile_bf16<8>(XN + (size_t)tm * 256 * 1024, 1024,
                       (const bf16_t*)(ws + OFF_WOIN) + ((size_t)li2 * 3072 + tn * 128) * 1024, 1024, 1024,
                       PR + (size_t)tm * 256 * 3072 + tn * 128, 3072, smem);
      }
      gbar(xb);
      if (STOP == 11) return;
      {
        bf16_t* AO = (bf16_t*)(ws + OFF_AO);
        const float* cw = p.odd_conv + (size_t)li2 * 3 * 1024;
        for (int i = blockIdx.x * 256 + tid; i < T_TOK * 128; i += G * 256) {
          const int t = i >> 7, c8 = (i & 127) * 8;
          const int s = t & 4095;
          const bf16_t* row = PR + (size_t)t * 3072;
          const u32x4 bg = *(const u32x4*)(row + c8);
          float u[3][8];
#pragma unroll
          for (int dt = 0; dt < 3; ++dt) {
            if (s - dt >= 0) {
              const u32x4 cg4 = *(const u32x4*)(row - (size_t)dt * 3072 + 1024 + c8);
              const u32x4 hx4 = *(const u32x4*)(row - (size_t)dt * 3072 + 2048 + c8);
              u[dt][0] = bf_lo(cg4.x) * bf_lo(hx4.x); u[dt][1] = bf_hi(cg4.x) * bf_hi(hx4.x);
              u[dt][2] = bf_lo(cg4.y) * bf_lo(hx4.y); u[dt][3] = bf_hi(cg4.y) * bf_hi(hx4.y);
              u[dt][4] = bf_lo(cg4.z) * bf_lo(hx4.z); u[dt][5] = bf_hi(cg4.z) * bf_hi(hx4.z);
              u[dt][6] = bf_lo(cg4.w) * bf_lo(hx4.w); u[dt][7] = bf_hi(cg4.w) * bf_hi(hx4.w);
            } else {
#pragma unroll
              for (int e = 0; e < 8; ++e) u[dt][e] = 0.f;
            }
          }
          const float bgf[8] = {bf_lo(bg.x), bf_hi(bg.x), bf_lo(bg.y), bf_hi(bg.y), bf_lo(bg.z), bf_hi(bg.z), bf_lo(bg.w), bf_hi(bg.w)};
          float y[8];
#pragma unroll
          for (int e = 0; e < 8; ++e) {
            const float w0 = cw[c8 + e], w1 = cw[1024 + c8 + e], w2 = cw[2048 + c8 + e];
            y[e] = bgf[e] * (w0 * u[2][e] + w1 * u[1][e] + w2 * u[0][e]);
          }
          u32x4 o;
          o.x = pk_bf16(y[0], y[1]); o.y = pk_bf16(y[2], y[3]); o.z = pk_bf16(y[4], y[5]); o.w = pk_bf16(y[6], y[7]);
          *(u32x4*)(AO + (size_t)t * 1024 + c8) = o;
        }
      }
      gbar(xb);
      if (STOP == 12) return;
      for (int it = blockIdx.x; it < 64 * 8; it += G) {
        const int tm = (it & 7) * 8 + ((it >> 3) >> 3), tn = (it >> 3) & 7;
        gemm_tile_f32<true, 8>((const bf16_t*)(ws + OFF_AO) + (size_t)tm * 256 * 1024, 1024,
                            (const bf16_t*)(ws + OFF_WOOUT) + ((size_t)li2 * 1024 + tn * 128) * 1024, 1024, 1024,
                            H + (size_t)tm * 256 * 1024 + tn * 128, 1024, smem);
      }
      gbar(xb);
      if (STOP == 13) return;
    }
    rmsnorm_rows(H, p.norm_ffn + (size_t)layer * 1024, (bf16_t*)(ws + OFF_XN), nullptr, (unsigned char*)(ws + OFF_AO) + (32ull << 20));
    gbar(xb);
      if (STOP == 7) return;
    {
      bf16_t* SCB = (bf16_t*)(ws + OFF_R + R_SC_BYTES);
      for (int rep = 0; rep < REP_E; ++rep)
      for (int it = blockIdx.x; it < 64 * 16; it += G) {
        const int tm = (it & 7) * 8 + ((it >> 3) >> 4), tn = (it >> 3) & 15;
        gemm_tile_bf16<8, true>((const bf16_t*)(ws + OFF_AO + (32ull << 20)) + (size_t)tm * 256 * 512, 512,
                       (const bf16_t*)(ws + OFF_WPQ) + ((size_t)layer * 2048 + tn * 128) * 512, 512, 512,
                       SCB + (size_t)tm * 256 * 2048 + tn * 128, 2048, smem);
      }
      gbar(xb);
      if (STOP == 8) return;
    }
    for (int rep = 0; rep < REP_F; ++rep)
    for (int it = blockIdx.x; it < T_TOK / 4; it += G) peer_token(p, layer, it * 4 + (otid() >> 6), rep + 1 < REP_F, smem);
    gbar(xb);
      if (STOP == 10) return;
  }
}

extern "C" void kernel_launch(void* const* d_in, const int* in_sizes, int n_in, void* d_out, int out_size, void* d_ws,
                              size_t ws_size, hipStream_t stream) {
  static int grid_blocks = 0;
  if (!grid_blocks) {
    int dev = 0, cus = 0, per_cu = 0;
    hipGetDevice(&dev);
    hipDeviceGetAttribute(&cus, hipDeviceAttributeMultiprocessorCount, dev);
    hipOccupancyMaxActiveBlocksPerMultiprocessor(&per_cu, fwd_kernel, 256, 0);
    if (per_cu > 2) per_cu = 2;
    grid_blocks = cus * per_cu;
  }
  if (ws_size < WS_NEED) {
    fprintf(stderr, "workspace too small: %zu < %zu\n", ws_size, (size_t)WS_NEED);
    return;
  }
  P p{};
  p.x = (const float*)d_in[0];
  p.norm_mix = (const float*)d_in[1];
  p.norm_ffn = (const float*)d_in[2];
  p.even_w_in = (const float*)d_in[3];
  p.even_w_out = (const float*)d_in[4];
  p.odd_w_in = (const float*)d_in[5];
  p.odd_conv = (const float*)d_in[6];
  p.odd_w_out = (const float*)d_in[7];
  p.peer_w_q = (const float*)d_in[8];
  p.peer_sub_keys = (const float*)d_in[9];
  p.peer_u = (const float*)d_in[10];
  p.peer_v = (const float*)d_in[11];
  p.final_norm = (const float*)d_in[12];
  p.out = (float*)d_out;
  p.ws = (char*)d_ws;
  (void)hipMemsetAsync(d_ws, 0, 16384, stream);
  void* args[] = {&p};
  hipError_t e = hipLaunchCooperativeKernel((void*)fwd_kernel, dim3(grid_blocks), dim3(256), args, 0, stream);
  if (e != hipSuccess) {
    fprintf(stderr, "cooperative launch failed: %s (grid %d)\n", hipGetErrorString(e), grid_blocks);
    (void)hipGetLastError();
    grid_blocks = 256;
    e = hipLaunchCooperativeKernel((void*)fwd_kernel, dim3(grid_blocks), dim3(256), args, 0, stream);
    if (e != hipSuccess) fprintf(stderr, "cooperative launch failed again: %s\n", hipGetErrorString(e));
  }
}
```

```cpp
#include <hip/hip_runtime.h>
#include <hip/hip_cooperative_groups.h>
#include <cstdio>
namespace cg = cooperative_groups;

typedef unsigned short bf16_t;
typedef short bf16x8 __attribute__((ext_vector_type(8)));
typedef float f32x4 __attribute__((ext_vector_type(4)));
typedef unsigned u32x4 __attribute__((ext_vector_type(4)));
typedef unsigned u32x2 __attribute__((ext_vector_type(2)));
typedef float f32x2 __attribute__((ext_vector_type(2)));
typedef int i32x8 __attribute__((ext_vector_type(8)));
__device__ __forceinline__ f32x4 MAKEF4(float a, float b, float c, float d) { f32x4 r = {a, b, c, d}; return r; }

#ifndef STOP
#define STOP 99
#endif
#ifndef REP_E
#define REP_E 1
#endif
#ifndef REP_B1
#define REP_B1 1
#endif
#ifndef REP_A
#define REP_A 1
#endif
#ifndef REP_B3
#define REP_B3 1
#endif
#ifndef REP_F
#define REP_F 1
#endif
#define T_TOK 16384
#define DM 1024
#define SEQL 4096

constexpr size_t OFF_BAR   = 0;
constexpr size_t OFF_COS   = 16384;
constexpr size_t OFF_SIN   = OFF_COS + 4096ull * 64 * 4;
constexpr size_t OFF_KPART = OFF_SIN + 4096ull * 64 * 4;
constexpr size_t OFF_WEIN  = OFF_KPART + 256ull * 4 * 128 * 4;
constexpr size_t OFF_WEOUT = OFF_WEIN + 2ull * 3584 * 1024 * 2;
constexpr size_t OFF_WOIN  = OFF_WEOUT + 2ull * 1024 * 2048 * 2;
constexpr size_t OFF_WOOUT = OFF_WOIN + 2ull * 3072 * 1024 * 2;
constexpr size_t OFF_WPQ   = OFF_WOOUT + 2ull * 1024 * 1024 * 2;
constexpr size_t OFF_SUBK  = OFF_WPQ + 4ull * 2048 * 1024 * 2;
constexpr size_t OFF_U     = OFF_SUBK + 4ull * 8 * 2 * 128 * 128 * 2;
constexpr size_t OFF_V     = OFF_U + 4ull * 16384 * 1024 * 2;
constexpr size_t OFF_H     = OFF_V + 4ull * 16384 * 1024 * 2;
constexpr size_t OFF_XN    = OFF_H + 16384ull * 1024 * 4;
constexpr size_t OFF_R     = OFF_XN + 16384ull * 1024 * 2;
constexpr size_t R_BYTES   = 192ull << 20;
constexpr size_t OFF_AO    = OFF_R + R_BYTES;
constexpr size_t OFF_S     = OFF_AO + 16384ull * 2048 * 2;
constexpr size_t OFF_ST    = OFF_S + 16ull * 32 * 128 * 128 * 4;
constexpr size_t WS_NEED   = OFF_ST + 16ull * 32 * 128 * 128 * 2;
constexpr size_t HEADBUF = 16ull * 4096 * 128;
constexpr size_t R_MQ = 0, R_MK = HEADBUF, R_MVT = 2 * HEADBUF, R_RQ = 3 * HEADBUF, R_RK = 4 * HEADBUF,
                 R_RKT = 5 * HEADBUF, R_RVT = 6 * HEADBUF, R_RG = 7 * HEADBUF;
constexpr size_t R_SC_BYTES = 64ull << 20;

struct P {
  const float *x, *norm_mix, *norm_ffn, *even_w_in, *even_w_out, *odd_w_in, *odd_conv, *odd_w_out,
      *peer_w_q, *peer_sub_keys, *peer_u, *peer_v, *final_norm;
  float* out;
  char* ws;
};

__device__ __forceinline__ int otid() { int t = threadIdx.x; asm volatile("" : "+v"(t)); return t; }
typedef __attribute__((address_space(1))) char gchar_t;
__device__ __forceinline__ char* opaque(char* q) { size_t z = 0; asm volatile("" : "+s"(z)); return q + z; }
typedef __bf16 bf16x2_t __attribute__((ext_vector_type(2)));
__device__ __forceinline__ unsigned pk_bf16(float lo, float hi) {
  bf16x2_t v = {(__bf16)lo, (__bf16)hi};
  return __builtin_bit_cast(unsigned, v);
}
__device__ __forceinline__ bf16_t f2bf(float f) { return (bf16_t)(pk_bf16(f, 0.f) & 0xffffu); }
__device__ __forceinline__ float bf_lo(unsigned u) { return __uint_as_float(u << 16); }
__device__ __forceinline__ float bf_hi(unsigned u) { return __uint_as_float(u & 0xffff0000u); }
__device__ __forceinline__ float bf2f(bf16_t h) { return __uint_as_float(((unsigned)h) << 16); }

template <int CTRL>
__device__ __forceinline__ unsigned dpp_u(unsigned x) {
  return (unsigned)__builtin_amdgcn_update_dpp(0, (int)x, CTRL, 0xF, 0xF, false);
}
__device__ __forceinline__ unsigned rowmax_u(unsigned x) {
  unsigned y;
  y = dpp_u<0x121>(x); x = x > y ? x : y;
  y = dpp_u<0x122>(x); x = x > y ? x : y;
  y = dpp_u<0x124>(x); x = x > y ? x : y;
  y = dpp_u<0x128>(x); x = x > y ? x : y;
  return x;
}
__device__ __forceinline__ float rowsum_f(float x) {
  x += __uint_as_float(dpp_u<0x121>(__float_as_uint(x)));
  x += __uint_as_float(dpp_u<0x122>(__float_as_uint(x)));
  x += __uint_as_float(dpp_u<0x124>(__float_as_uint(x)));
  x += __uint_as_float(dpp_u<0x128>(__float_as_uint(x)));
  return x;
}
__device__ __forceinline__ float rdlane_f(float x, int l) {
  return __uint_as_float((unsigned)__builtin_amdgcn_readlane((int)__float_as_uint(x), l));
}
__device__ __forceinline__ float wavesum_f(float x) {
  x = rowsum_f(x);
  return rdlane_f(x, 0) + rdlane_f(x, 16) + rdlane_f(x, 32) + rdlane_f(x, 48);
}
__device__ __forceinline__ unsigned f_ord(float v) {
  unsigned u = __float_as_uint(v);
  return (u & 0x80000000u) ? ~u : (u | 0x80000000u);
}
__device__ __forceinline__ float f_deord(unsigned u) {
  return __uint_as_float((u & 0x80000000u) ? (u ^ 0x80000000u) : ~u);
}

#define XB_TMO 128
#define XB_XCNT(j) (256 + 64 * (j))
#define XB_XSUB(j) (1280 + 64 * (j))
#define XB_XGEN(j) (2304 + 64 * (j))
#define XB_TOP 3328
#define XB_TOPGEN 3392
#define XB_SPIN_CAP (1u << 22)
__device__ __forceinline__ unsigned xb_ld(unsigned* q) { return __hip_atomic_load(q, __ATOMIC_RELAXED, __HIP_MEMORY_SCOPE_AGENT); }
__device__ __forceinline__ unsigned xb_add(unsigned* q, unsigned v) { return __hip_atomic_fetch_add(q, v, __ATOMIC_RELAXED, __HIP_MEMORY_SCOPE_AGENT); }
#define XB_SPIN(cond, bar) do { unsigned _sp = 0; while (cond) { __builtin_amdgcn_s_sleep(1); \
    if ((++_sp & 255u) == 0u) { if (xb_ld(&(bar)[XB_TMO])) break; if (_sp > XB_SPIN_CAP) { atomicAdd(&(bar)[XB_TMO], 1u); break; } } } } while (0)
struct XB { unsigned* bar; unsigned x, nloc, nx; };
__device__ __forceinline__ void xb_complete(unsigned* bar, unsigned x, unsigned& nloc, unsigned& nx) {
  const unsigned G = gridDim.x;
  unsigned sum, cnt, mine, sp = 0u;
  for (;;) {
    sum = 0u; cnt = 0u; mine = 0u;
#pragma unroll
    for (unsigned j = 0; j < 16; ++j) { const unsigned c = xb_ld(&bar[XB_XCNT(j)]); sum += c; cnt += (c > 0u) ? 1u : 0u; mine = (j == x) ? c : mine; }
    if (sum == G) break;
    __builtin_amdgcn_s_sleep(1);
    if ((++sp & 255u) == 0u) { if (xb_ld(&bar[XB_TMO])) break; if (sp > XB_SPIN_CAP) { atomicAdd(&bar[XB_TMO], 1u); break; } }
  }
  nloc = mine > 0u ? mine : 1u; nx = cnt > 0u ? cnt : 1u;
}
__device__ __forceinline__ void gbar(XB& b) {
  asm volatile("s_waitcnt vmcnt(0) lgkmcnt(0)" ::: "memory");
  __syncthreads();
  if (threadIdx.x == 0) {
    unsigned* bar = b.bar;
    if (b.nloc == 0u) xb_complete(bar, b.x, b.nloc, b.nx);
    const unsigned nloc = b.nloc, nx = b.nx;
    const unsigned old = xb_add(&bar[XB_XSUB(b.x)], 1u);
    const unsigned gen = old / nloc;
    if (old + 1u == (gen + 1u) * nloc) {
      __builtin_amdgcn_fence(__ATOMIC_RELEASE, "agent");
      asm volatile("s_waitcnt vmcnt(0)" ::: "memory");
      const unsigned og = xb_add(&bar[XB_TOP], 1u);
      const unsigned tg = og / nx;
      if (og + 1u == (tg + 1u) * nx) xb_add(&bar[XB_TOPGEN], 1u);
      else XB_SPIN(xb_ld(&bar[XB_TOPGEN]) == tg, bar);
      __builtin_amdgcn_fence(__ATOMIC_ACQUIRE, "agent");
      xb_add(&bar[XB_XGEN(b.x)], 1u);
      asm volatile("s_waitcnt vmcnt(0)" ::: "memory");
    } else {
      XB_SPIN(xb_ld(&bar[XB_XGEN(b.x)]) == gen, bar);
      __builtin_amdgcn_fence(__ATOMIC_ACQUIRE, "agent");
      asm volatile("s_waitcnt vmcnt(0)" ::: "memory");
    }
  }
  __syncthreads();
}

template <int MI, bool SWAP, bool F8 = false>
__device__ __forceinline__ void gemm_core(const bf16_t* __restrict__ A, int lda, const bf16_t* __restrict__ B, int ldb,
                                          int K, char* smem, f32x4 (&acc)[MI][4]) {
  const int tid = otid(), lane = tid & 63, w = tid >> 6, wm = w >> 1, wn = w & 1;
  const int lr = tid >> 3, lc = tid & 7;
  const int li = lane & 15, g = lane >> 4;
  u32x4 ra[MI], rb[4];
  const bf16_t* ap = A + (size_t)lr * lda + lc * 8;
  const bf16_t* bp = B + (size_t)lr * ldb + lc * 8;
#pragma unroll
  for (int i = 0; i < MI; ++i)
#pragma unroll
    for (int j = 0; j < 4; ++j) acc[i][j] = (f32x4){0.f, 0.f, 0.f, 0.f};
  const int nk = K >> 6;
#pragma unroll
  for (int i = 0; i < MI; ++i) ra[i] = *(const u32x4*)(ap + (size_t)(32 * i) * lda);
#pragma unroll
  for (int i = 0; i < 4; ++i) rb[i] = *(const u32x4*)(bp + (size_t)(32 * i) * ldb);
  const int woff = lr * 128 + ((lc ^ (lr & 7)) << 4);
  const int xrow = (wm * 16 * MI + li) * 128;
  const int wrow = 32768 + (wn * 32 + li) * 128;
  for (int kt = 0; kt < nk; ++kt) {
    __syncthreads();
#pragma unroll
    for (int i = 0; i < MI; ++i) *(u32x4*)(smem + woff + i * 4096) = ra[i];
#pragma unroll
    for (int i = 0; i < 4; ++i) *(u32x4*)(smem + 32768 + woff + i * 4096) = rb[i];
    __syncthreads();
    if (kt + 1 < nk) {
#pragma unroll
      for (int i = 0; i < MI; ++i) ra[i] = *(const u32x4*)(ap + (size_t)(32 * i) * lda + (kt + 1) * 64);
#pragma unroll
      for (int i = 0; i < 4; ++i) rb[i] = *(const u32x4*)(bp + (size_t)(32 * i) * ldb + (kt + 1) * 64);
    }
    if (F8) {
      const int c0 = (g ^ (li & 7)) << 4, c1 = ((4 + g) ^ (li & 7)) << 4;
      i32x8 wf8[4];
#pragma unroll
      for (int j = 0; j < 4; ++j) {
        const char* rp = smem + wrow + ((j & 1) * 16 + (j >> 1) * 64) * 128;
        const u32x4 lo = *(const u32x4*)(rp + c0), hi = *(const u32x4*)(rp + c1);
        wf8[j] = (i32x8){(int)lo.x, (int)lo.y, (int)lo.z, (int)lo.w, (int)hi.x, (int)hi.y, (int)hi.z, (int)hi.w};
      }
#pragma unroll
      for (int i = 0; i < MI; ++i) {
        const char* rp = smem + xrow + i * 2048;
        const u32x4 lo = *(const u32x4*)(rp + c0), hi = *(const u32x4*)(rp + c1);
        const i32x8 xf8 = {(int)lo.x, (int)lo.y, (int)lo.z, (int)lo.w, (int)hi.x, (int)hi.y, (int)hi.z, (int)hi.w};
#pragma unroll
        for (int j = 0; j < 4; ++j)
          acc[i][j] = __builtin_amdgcn_mfma_scale_f32_16x16x128_f8f6f4(wf8[j], xf8, acc[i][j], 0, 0, 0, 0x77777777, 0, 0x7f7f7f7f);
      }
    } else {
#pragma unroll
    for (int kk = 0; kk < 2; ++kk) {
      const int ch = ((kk * 4 + g) ^ (li & 7)) << 4;
      bf16x8 xf[MI], wf[4];
#pragma unroll
      for (int j = 0; j < 4; ++j) wf[j] = *(const bf16x8*)(smem + wrow + ((j & 1) * 16 + (j >> 1) * 64) * 128 + ch);
#pragma unroll
      for (int i = 0; i < MI; ++i) xf[i] = *(const bf16x8*)(smem + xrow + i * 2048 + ch);
#pragma unroll
      for (int i = 0; i < MI; ++i)
#pragma unroll
        for (int j = 0; j < 4; ++j) {
          if (SWAP) acc[i][j] = __builtin_amdgcn_mfma_f32_16x16x32_bf16(xf[i], wf[j], acc[i][j], 0, 0, 0);
          else acc[i][j] = __builtin_amdgcn_mfma_f32_16x16x32_bf16(wf[j], xf[i], acc[i][j], 0, 0, 0);
        }
    }
    }
  }
}

#define EPI_COORDS                                                             \
  const int tid_ = otid(); const int lane = tid_ & 63, w = tid_ >> 6, wm = w >> 1, wn = w & 1; \
  const int li = lane & 15, g = lane >> 4;                                     \
  (void)wm; (void)wn; (void)li; (void)g;
#define NCOL(j) (((j) & 1) * 16 + wn * 32 + ((j) >> 1) * 64 + g * 4)
#define MROW(i) (wm * 16 * MI + (i) * 16 + li)
#define NCOLS(j) (((j) & 1) * 16 + wn * 32 + ((j) >> 1) * 64 + li)
#define MROWS(i) (wm * 16 * MI + (i) * 16 + g * 4)

template <int MI, bool F8 = false>
__device__ void gemm_tile_bf16(const bf16_t* A, int lda, const bf16_t* B, int ldb, int K, bf16_t* C, int ldc, char* smem) {
  f32x4 acc[MI][4];
  gemm_core<MI, false, F8>(A, lda, B, ldb, K, smem, acc);
  EPI_COORDS
#pragma unroll
  for (int i = 0; i < MI; ++i)
#pragma unroll
    for (int j = 0; j < 4; ++j) {
      u32x2 v;
      v.x = pk_bf16(acc[i][j][0], acc[i][j][1]);
      v.y = pk_bf16(acc[i][j][2], acc[i][j][3]);
      *(u32x2*)(C + (size_t)MROW(i) * ldc + NCOL(j)) = v;
    }
}
template <int MI>
__device__ void gemm_tile_fp8out(const bf16_t* A, int lda, const bf16_t* B, int ldb, int K, unsigned char* C, int ldc, float mul, char* smem) {
  f32x4 acc[MI][4];
  gemm_core<MI, false>(A, lda, B, ldb, K, smem, acc);
  EPI_COORDS
#pragma unroll
  for (int i = 0; i < MI; ++i)
#pragma unroll
    for (int j = 0; j < 4; ++j) {
      int wd = __builtin_amdgcn_cvt_pk_fp8_f32(acc[i][j][0] * mul, acc[i][j][1] * mul, 0, false);
      wd = __builtin_amdgcn_cvt_pk_fp8_f32(acc[i][j][2] * mul, acc[i][j][3] * mul, wd, true);
      *(int*)(C + (size_t)MROW(i) * ldc + NCOL(j)) = wd;
    }
}
template <bool ACCUM, int MI>
__device__ void gemm_tile_f32(const bf16_t* A, int lda, const bf16_t* B, int ldb, int K, float* C, int ldc, char* smem) {
  f32x4 acc[MI][4];
  gemm_core<MI, false>(A, lda, B, ldb, K, smem, acc);
  EPI_COORDS
#pragma unroll
  for (int i = 0; i < MI; ++i)
#pragma unroll
    for (int j = 0; j < 4; ++j) {
      f32x4* cp = (f32x4*)(C + (size_t)MROW(i) * ldc + NCOL(j));
      f32x4 v = acc[i][j];
      if (ACCUM) v += *cp;
      *cp = v;
    }
}

__device__ __constant__ float LOG2G[4] = {-0.04580368961312479f, -0.02272007650008353f, -0.011315313227834146f,
                                          -0.005646563141142063f};

__device__ void even_in_tile(const P& p, int li_even, int tm, int tn, char* smem) {
  constexpr int MI = 8;
  char* ws = opaque(p.ws);
  const bf16_t* A = (const bf16_t*)(ws + OFF_XN) + (size_t)tm * 256 * 1024;
  const bf16_t* B = (const bf16_t*)(ws + OFF_WEIN) + ((size_t)li_even * 3584 + (size_t)tn * 128) * 1024;
  const int seg = tn >> 2, hd = tn & 3;
  const int t0 = tm * 256, b = t0 >> 12, s0 = t0 & 4095, bh = b * 4 + hd;
  bf16_t* R = (bf16_t*)(ws + OFF_R);
  f32x4 acc[MI][4];
  if (seg == 2 || seg == 5) {
    gemm_core<MI, true>(A, 1024, B, 1024, 1024, smem, acc);
    EPI_COORDS
    bf16_t* dst = R + (seg == 2 ? R_MVT : R_RVT) + (size_t)bh * 128 * 4096;
#pragma unroll
    for (int i = 0; i < MI; ++i)
#pragma unroll
      for (int j = 0; j < 4; ++j) {
        u32x2 v;
        v.x = pk_bf16(acc[i][j][0], acc[i][j][1]);
        v.y = pk_bf16(acc[i][j][2], acc[i][j][3]);
        *(u32x2*)(dst + (size_t)NCOLS(j) * 4096 + s0 + MROWS(i)) = v;
      }
    return;
  }
  gemm_core<MI, false>(A, 1024, B, 1024, 1024, smem, acc);
  EPI_COORDS
  if (seg != 6) {
    const float* ctab = (const float*)(ws + OFF_COS);
    const float* stab = (const float*)(ws + OFF_SIN);
#pragma unroll
    for (int i = 0; i < MI; ++i) {
      const int s = s0 + MROW(i);
#pragma unroll
      for (int jj = 0; jj < 2; ++jj) {
        const int d = wn * 32 + jj * 16 + g * 4;
        const f32x4 c = *(const f32x4*)(ctab + s * 64 + d);
        const f32x4 sn = *(const f32x4*)(stab + s * 64 + d);
#pragma unroll
        for (int r = 0; r < 4; ++r) {
          const float a = acc[i][jj][r], bb = acc[i][jj + 2][r];
          acc[i][jj][r] = a * c[r] - bb * sn[r];
          acc[i][jj + 2][r] = bb * c[r] + a * sn[r];
        }
      }
    }
  }
  if (seg == 1) {
#pragma unroll
    for (int ih = 0; ih < 2; ++ih) {
      float* kp = (float*)(ws + OFF_KPART) + ((size_t)(tm * 4 + wm * 2 + ih) * 4 + hd) * 128;
#pragma unroll
      for (int j = 0; j < 4; ++j)
#pragma unroll
        for (int r = 0; r < 4; ++r) {
          float sm = acc[ih * 4][j][r] + acc[ih * 4 + 1][j][r] + acc[ih * 4 + 2][j][r] + acc[ih * 4 + 3][j][r];
          sm = rowsum_f(sm);
          if (li == 0) kp[NCOL(j) + r] = sm;
        }
    }
  }
  if (seg == 4) {
#pragma unroll
    for (int i = 0; i < MI; ++i)
#pragma unroll
      for (int j = 0; j < 4; ++j) acc[i][j] *= 0.08838834764831843f;
  }
  if (seg != 6) {
    bf16_t* dst = R + (seg == 0 ? R_MQ : seg == 1 ? R_MK : seg == 3 ? R_RQ : R_RK) + (size_t)bh * 4096 * 128;
#pragma unroll
    for (int i = 0; i < MI; ++i)
#pragma unroll
      for (int j = 0; j < 4; ++j) {
        u32x2 v;
        v.x = pk_bf16(acc[i][j][0], acc[i][j][1]);
        v.y = pk_bf16(acc[i][j][2], acc[i][j][3]);
        *(u32x2*)(dst + (size_t)(s0 + MROW(i)) * 128 + NCOL(j)) = v;
      }
  }
  if (seg == 4) {
    bf16_t* dst = R + R_RKT + (size_t)bh * 128 * 4096;
    const float lg = LOG2G[hd];
#pragma unroll
    for (int i = 0; i < MI; ++i) {
      const int s = s0 + MROW(i);
      const float z = exp2f((float)(127 - (s & 127)) * lg);
#pragma unroll
      for (int j = 0; j < 4; ++j)
#pragma unroll
        for (int r = 0; r < 4; ++r) dst[(size_t)(NCOL(j) + r) * 4096 + s] = f2bf(acc[i][j][r] * z);
    }
  }
  if (seg == 6) {
    bf16_t* dst = R + R_RG;
#pragma unroll
    for (int i = 0; i < MI; ++i)
#pragma unroll
      for (int j = 0; j < 4; ++j) {
        u32x2 v;
        v.x = pk_bf16(acc[i][j][0], acc[i][j][1]);
        v.y = pk_bf16(acc[i][j][2], acc[i][j][3]);
        *(u32x2*)(dst + (size_t)(t0 + MROW(i)) * 512 + hd * 128 + NCOL(j)) = v;
      }
  }
}

__device__ void tr_cvt_tiles(const float* src, bf16_t* dst, int K, int N, int nl, char* smem) {
  float(*t)[65] = (float(*)[65])smem;
  const int tk = K >> 6, tnn = N >> 6, per = tk * tnn, total = per * nl;
  const int tid = threadIdx.x;
  for (int it = blockIdx.x; it < total; it += gridDim.x) {
    const int l = it / per, rem = it % per, kt = rem / tnn, nt = rem % tnn;
    const float* s = src + (size_t)l * K * N + (size_t)kt * 64 * N + nt * 64;
    bf16_t* d = dst + (size_t)l * K * N + (size_t)nt * 64 * K + kt * 64;
    __syncthreads();
#pragma unroll
    for (int i = 0; i < 16; ++i) {
      const int e = tid + i * 256, r = e >> 6, c = e & 63;
      t[r][c] = s[(size_t)r * N + c];
    }
    __syncthreads();
#pragma unroll
    for (int i = 0; i < 16; ++i) {
      const int e = tid + i * 256, n = e >> 6, k = e & 63;
      d[(size_t)n * K + k] = f2bf(t[k][n]);
    }
  }
}
__device__ void cvt_straight(const float* src, bf16_t* dst, size_t n) {
  const size_t n4 = n >> 2;
  for (size_t i = (size_t)blockIdx.x * 256 + threadIdx.x; i < n4; i += (size_t)gridDim.x * 256) {
    const f32x4 v = ((const f32x4*)src)[i];
    u32x2 o;
    o.x = pk_bf16(v.x, v.y);
    o.y = pk_bf16(v.z, v.w);
    ((u32x2*)dst)[i] = o;
  }
}
__device__ void rmsnorm_rows(const float* src, const float* gw, bf16_t* dst, float* copy, unsigned char* dst8 = nullptr) {
  const int tid_ = otid(); const int lane = tid_ & 63, w = tid_ >> 6;
  f32x4 gg[4];
#pragma unroll
  for (int k = 0; k < 4; ++k) gg[k] = ((const f32x4*)gw)[lane + 64 * k];
  const int stride = gridDim.x * 4;
  for (int row0 = blockIdx.x * 4 + w; row0 < T_TOK; row0 += stride * 4) {
    f32x4 v[4][4];
#pragma unroll
    for (int rr = 0; rr < 4; ++rr) {
      const int row = row0 + rr * stride;
      if (row < T_TOK) {
        const f32x4* sp = (const f32x4*)(src + (size_t)row * 1024);
#pragma unroll
        for (int k = 0; k < 4; ++k) v[rr][k] = sp[lane + 64 * k];
      }
    }
#pragma unroll
    for (int rr = 0; rr < 4; ++rr) {
      const int row = row0 + rr * stride;
      if (row < T_TOK) {
        float ss = 0.f;
#pragma unroll
        for (int k = 0; k < 4; ++k) ss += v[rr][k].x * v[rr][k].x + v[rr][k].y * v[rr][k].y + v[rr][k].z * v[rr][k].z + v[rr][k].w * v[rr][k].w;
        ss = wavesum_f(ss);
        const float rs = rsqrtf(ss * (1.f / 1024.f) + 1e-6f);
#pragma unroll
        for (int k = 0; k < 4; ++k) {
          const f32x4 y = v[rr][k] * rs * gg[k];
          u32x2 o;
          o.x = pk_bf16(y.x, y.y);
          o.y = pk_bf16(y.z, y.w);
          if (dst) ((u32x2*)(dst + (size_t)row * 1024))[lane + 64 * k] = o;
          if (dst8) {
            int wd = __builtin_amdgcn_cvt_pk_fp8_f32(y.x, y.y, 0, false);
            wd = __builtin_amdgcn_cvt_pk_fp8_f32(y.z, y.w, wd, true);
            ((int*)(dst8 + (size_t)row * 1024))[lane + 64 * k] = wd;
          }
          if (copy) ((f32x4*)(copy + (size_t)row * 1024))[lane + 64 * k] = v[rr][k];
        }
      }
    }
  }
}

__device__ void moba_item(const P& p, int bh, int qt, char* smem) {
  char* ws = opaque(p.ws);
  const bf16_t* R = (const bf16_t*)(ws + OFF_R);
  const bf16_t* Q = R + R_MQ + (size_t)bh * 4096 * 128;
  const bf16_t* Kp = R + R_MK + (size_t)bh * 4096 * 128;
  const bf16_t* VT = R + R_MVT + (size_t)bh * 128 * 4096;
  const int b = bh >> 2, hd = bh & 3;
  const int qblk = qt >> 2, qin = qt & 3;
  const int q0 = qt * 64;
  const int tid = otid(), lane = tid & 63, w = tid >> 6, li = lane & 15, g = lane >> 4;
  char* sK = smem;
  char* sV = smem + 16384;
  float* sGate = (float*)(smem + 32768);
  unsigned* sMask = (unsigned*)(smem + 36864);
  float* sKm = (float*)(smem + 37120);
  __syncthreads();
  {
    const float* kp = (const float*)(ws + OFF_KPART);
    for (int e = tid; e < qblk * 128; e += 256) {
      const int n = e >> 7, d = e & 127;
      float sm = 0.f;
#pragma unroll
      for (int x4 = 0; x4 < 4; ++x4) sm += kp[((size_t)(b * 64 + n * 4 + x4) * 4 + hd) * 128 + d];
      sKm[n * 132 + d] = sm * (1.f / 256.f);
    }
  }
  __syncthreads();
  {
    const int q = tid >> 2, nb = (tid & 3) * 4;
    const u32x4* qp = (const u32x4*)(Q + (size_t)(q0 + q) * 128);
    float gsum[4] = {0.f, 0.f, 0.f, 0.f};
    u32x4 qrow[16];
#pragma unroll
    for (int c = 0; c < 16; ++c) qrow[c] = qp[c];
#pragma unroll
    for (int c = 0; c < 16; ++c) {
      const u32x4 u = qrow[c];
      const float qv[8] = {bf_lo(u.x), bf_hi(u.x), bf_lo(u.y), bf_hi(u.y), bf_lo(u.z), bf_hi(u.z), bf_lo(u.w), bf_hi(u.w)};
#pragma unroll
      for (int nn = 0; nn < 4; ++nn) {
        if (nb + nn < qblk) {
          const float* km = sKm + (nb + nn) * 132 + c * 8;
#pragma unroll
          for (int e = 0; e < 8; ++e) gsum[nn] += qv[e] * km[e];
        }
      }
    }
#pragma unroll
    for (int nn = 0; nn < 4; ++nn) sGate[q * 16 + nb + nn] = gsum[nn];
  }
  __syncthreads();
  if (tid < 64) {
    unsigned m = 0;
    for (int n = 0; n < qblk; ++n) {
      const float gn = sGate[tid * 16 + n];
      int rank = 0;
      for (int mm = 0; mm < qblk; ++mm) {
        const float gm = sGate[tid * 16 + mm];
        rank += (gm > gn || (gm == gn && mm < n)) ? 1 : 0;
      }
      if (rank < 3) m |= 1u << n;
    }
    sMask[tid] = m;
  }
  __syncthreads();
  const unsigned mymask = sMask[w * 16 + li];
  const int qpos = q0 + w * 16 + li;
  bf16x8 qf[4];
#pragma unroll
  for (int kk = 0; kk < 4; ++kk) qf[kk] = *(const bf16x8*)(Q + (size_t)qpos * 128 + (kk * 4 + g) * 8);
  f32x4 oacc[8];
#pragma unroll
  for (int d = 0; d < 8; ++d) oacc[d] = (f32x4){0.f, 0.f, 0.f, 0.f};
  float mrun = -INFINITY, lrun = 0.f;
  const int ntiles = qblk * 4 + qin + 1;
  const int kr = tid >> 4, kc = tid & 15;
  const int vr = tid >> 3, vc = tid & 7;
  u32x4 rkA[4], rvA[4], rkB[4], rvB[4];
#pragma unroll
  for (int i = 0; i < 4; ++i) {
    rkA[i] = *(const u32x4*)(Kp + (size_t)(kr + 16 * i) * 128 + kc * 8);
    rvA[i] = *(const u32x4*)(VT + (size_t)(vr + 32 * i) * 4096 + vc * 8);
  }
  if (ntiles > 1) {
#pragma unroll
    for (int i = 0; i < 4; ++i) {
      rkB[i] = *(const u32x4*)(Kp + (size_t)(64 + kr + 16 * i) * 128 + kc * 8);
      rvB[i] = *(const u32x4*)(VT + (size_t)(vr + 32 * i) * 4096 + 64 + vc * 8);
    }
  }
  const float SC = 0.12751743082459868f;
  auto step = [&](const int tt, u32x4 (&rk)[4], u32x4 (&rv)[4]) __attribute__((always_inline)) {
    __syncthreads();
#pragma unroll
    for (int i = 0; i < 4; ++i) {
      const int row = kr + 16 * i;
      const int f = ((row >> 3) & 3) * 4 + (row & 3);
      *(u32x4*)(sK + row * 256 + ((kc ^ f) << 4)) = rk[i];
      const int vrow = vr + 32 * i;
      *(u32x4*)(sV + vrow * 128 + ((vc ^ (vrow & 7)) << 4)) = rv[i];
    }
    __syncthreads();
    if (tt + 2 < ntiles) {
      const int k1 = (tt + 2) * 64;
#pragma unroll
      for (int i = 0; i < 4; ++i) {
        rk[i] = *(const u32x4*)(Kp + (size_t)(k1 + kr + 16 * i) * 128 + kc * 8);
        rv[i] = *(const u32x4*)(VT + (size_t)(vr + 32 * i) * 4096 + k1 + vc * 8);
      }
    }
    const int blk = tt >> 2;
    const bool own = (blk == qblk);
    const bool rowvalid = own || ((mymask >> blk) & 1u);
    if (__any(rowvalid)) {
      const int key0 = tt * 64;
      f32x4 sacc[2][2];
#pragma unroll
      for (int st = 0; st < 2; ++st)
#pragma unroll
        for (int kt = 0; kt < 2; ++kt) {
          sacc[st][kt] = (f32x4){0.f, 0.f, 0.f, 0.f};
          const int row = 32 * st + 8 * (li >> 2) + 4 * kt + (li & 3);
#pragma unroll
          for (int kk = 0; kk < 4; ++kk) {
            const bf16x8 kf = *(const bf16x8*)(sK + row * 256 + (((kk * 4 + g) ^ li) << 4));
            sacc[st][kt] = __builtin_amdgcn_mfma_f32_16x16x32_bf16(kf, qf[kk], sacc[st][kt], 0, 0, 0);
          }
        }
      const bool diag = (tt == ntiles - 1);
      float mx = -INFINITY;
      if (diag || !__all(rowvalid)) {
#pragma unroll
        for (int st = 0; st < 2; ++st)
#pragma unroll
          for (int kt = 0; kt < 2; ++kt)
#pragma unroll
            for (int r = 0; r < 4; ++r) {
              const int key = key0 + 32 * st + 8 * g + 4 * kt + r;
              bool ok = rowvalid && (!diag || key <= qpos);
              const float sv = ok ? sacc[st][kt][r] * SC : -INFINITY;
              sacc[st][kt][r] = sv;
              mx = fmaxf(mx, sv);
            }
      } else {
#pragma unroll
        for (int st = 0; st < 2; ++st)
#pragma unroll
          for (int kt = 0; kt < 2; ++kt) {
            sacc[st][kt] *= SC;
            mx = fmaxf(mx, fmaxf(fmaxf(sacc[st][kt][0], sacc[st][kt][1]), fmaxf(sacc[st][kt][2], sacc[st][kt][3])));
          }
      }
      mx = fmaxf(mx, __shfl_xor(mx, 16));
      mx = fmaxf(mx, __shfl_xor(mx, 32));
      const float mnew = (mx > mrun + 6.f) ? mx : mrun;
      const float muse = (mnew == -INFINITY) ? 0.f : mnew;
      const bool resc = __any(mnew != mrun);
      const float alpha = __builtin_amdgcn_exp2f(mrun - muse);
      mrun = mnew;
      float ps = 0.f;
      bf16x8 pf[2];
#pragma unroll
      for (int st = 0; st < 2; ++st) {
        float pv[8];
#pragma unroll
        for (int kt = 0; kt < 2; ++kt)
#pragma unroll
          for (int r = 0; r < 4; ++r) {
            const float e = __builtin_amdgcn_exp2f(sacc[st][kt][r] - muse);
            pv[kt * 4 + r] = e;
            ps += e;
          }
        u32x4 u;
        u.x = pk_bf16(pv[0], pv[1]); u.y = pk_bf16(pv[2], pv[3]); u.z = pk_bf16(pv[4], pv[5]); u.w = pk_bf16(pv[6], pv[7]);
        pf[st] = *(bf16x8*)&u;
      }
      lrun = lrun * alpha + ps;
      if (resc) {
#pragma unroll
        for (int d = 0; d < 8; ++d) oacc[d] *= alpha;
      }
#pragma unroll
      for (int d = 0; d < 8; ++d) {
        const int row = d * 16 + li;
#pragma unroll
        for (int st = 0; st < 2; ++st) {
          const bf16x8 vf = *(const bf16x8*)(sV + row * 128 + (((st * 4 + g) ^ (li & 7)) << 4));
          oacc[d] = __builtin_amdgcn_mfma_f32_16x16x32_bf16(vf, pf[st], oacc[d], 0, 0, 0);
        }
      }
    }
    };
  for (int tt = 0; tt < ntiles; tt += 2) {
    step(tt, rkA, rvA);
    if (tt + 1 < ntiles) step(tt + 1, rkB, rvB);
  }
  lrun += __shfl_xor(lrun, 16);
  lrun += __shfl_xor(lrun, 32);
  const float inv = 1.f / lrun;
  bf16_t* ao = (bf16_t*)(ws + OFF_AO) + (size_t)(b * 4096 + qpos) * 1024 + hd * 128;
#pragma unroll
  for (int d = 0; d < 8; ++d) {
    u32x2 v;
    v.x = pk_bf16(oacc[d][0] * inv, oacc[d][1] * inv);
    v.y = pk_bf16(oacc[d][2] * inv, oacc[d][3] * inv);
    *(u32x2*)(ao + d * 16 + g * 4) = v;
  }
}

__device__ void ret_out_item(const P& p, int bh, int c) {
  char* ws = opaque(p.ws);
  const bf16_t* R = (const bf16_t*)(ws + OFF_R);
  const int b = bh >> 2, hd = bh & 3;
  const bf16_t* Q = R + R_RQ + ((size_t)bh * 4096 + c * 128) * 128;
  const bf16_t* Kp = R + R_RK + ((size_t)bh * 4096 + c * 128) * 128;
  const bf16_t* VT = R + R_RVT + (size_t)bh * 128 * 4096 + c * 128;
  const bf16_t* ST = (const bf16_t*)(ws + OFF_ST) + (size_t)(bh * 32 + c) * 16384;
  const int tid_ = otid(); const int lane = tid_ & 63, w = tid_ >> 6, li = lane & 15, g = lane >> 4;
  const float lg = LOG2G[hd];
  bf16x8 qf[2][4];
#pragma unroll
  for (int ns = 0; ns < 2; ++ns)
#pragma unroll
    for (int kk = 0; kk < 4; ++kk) qf[ns][kk] = *(const bf16x8*)(Q + (size_t)(32 * w + 16 * ns + li) * 128 + (kk * 4 + g) * 8);
  f32x4 acc[8][2];
#pragma unroll
  for (int es = 0; es < 8; ++es)
#pragma unroll
    for (int ns = 0; ns < 2; ++ns) acc[es][ns] = (f32x4){0.f, 0.f, 0.f, 0.f};
  if (c > 0) {
#pragma unroll
    for (int es = 0; es < 8; ++es)
#pragma unroll
      for (int kk = 0; kk < 4; ++kk) {
        const bf16x8 sf = *(const bf16x8*)(ST + (size_t)(es * 16 + li) * 128 + (kk * 4 + g) * 8);
#pragma unroll
        for (int ns = 0; ns < 2; ++ns) acc[es][ns] = __builtin_amdgcn_mfma_f32_16x16x32_bf16(sf, qf[ns][kk], acc[es][ns], 0, 0, 0);
      }
#pragma unroll
    for (int ns = 0; ns < 2; ++ns) {
      const float xi = exp2f((float)(32 * w + 16 * ns + li + 1) * lg);
#pragma unroll
      for (int es = 0; es < 8; ++es) {
        acc[es][ns][0] *= xi; acc[es][ns][1] *= xi; acc[es][ns][2] *= xi; acc[es][ns][3] *= xi;
      }
    }
  }
  for (int ms = 0; ms <= w; ++ms) {
    f32x4 sacc[2][2];
#pragma unroll
    for (int kt = 0; kt < 2; ++kt) {
      const int row = 32 * ms + 8 * (li >> 2) + 4 * kt + (li & 3);
#pragma unroll
      for (int ns = 0; ns < 2; ++ns) sacc[kt][ns] = (f32x4){0.f, 0.f, 0.f, 0.f};
#pragma unroll
      for (int kk = 0; kk < 4; ++kk) {
        const bf16x8 kf = *(const bf16x8*)(Kp + (size_t)row * 128 + (kk * 4 + g) * 8);
#pragma unroll
        for (int ns = 0; ns < 2; ++ns) sacc[kt][ns] = __builtin_amdgcn_mfma_f32_16x16x32_bf16(kf, qf[ns][kk], sacc[kt][ns], 0, 0, 0);
      }
    }
    bf16x8 pf[2];
#pragma unroll
    for (int ns = 0; ns < 2; ++ns) {
      const int n = 32 * w + 16 * ns + li;
      float pv[8];
#pragma unroll
      for (int kt = 0; kt < 2; ++kt)
#pragma unroll
        for (int r = 0; r < 4; ++r) {
          const int m = 32 * ms + 8 * g + 4 * kt + r;
          const float dec = (n >= m) ? exp2f((float)(n - m) * lg) : 0.f;
          pv[kt * 4 + r] = sacc[kt][ns][r] * dec;
        }
      u32x4 u;
      u.x = pk_bf16(pv[0], pv[1]); u.y = pk_bf16(pv[2], pv[3]); u.z = pk_bf16(pv[4], pv[5]); u.w = pk_bf16(pv[6], pv[7]);
      pf[ns] = *(bf16x8*)&u;
    }
#pragma unroll
    for (int es = 0; es < 8; ++es) {
      const bf16x8 vf = *(const bf16x8*)(VT + (size_t)(es * 16 + li) * 4096 + 32 * ms + 8 * g);
#pragma unroll
      for (int ns = 0; ns < 2; ++ns) acc[es][ns] = __builtin_amdgcn_mfma_f32_16x16x32_bf16(vf, pf[ns], acc[es][ns], 0, 0, 0);
    }
  }
  const bf16_t* RG = R + R_RG;
  bf16_t* ao = (bf16_t*)(ws + OFF_AO);
#pragma unroll
  for (int ns = 0; ns < 2; ++ns) {
    float ss = 0.f;
#pragma unroll
    for (int es = 0; es < 8; ++es)
#pragma unroll
      for (int r = 0; r < 4; ++r) ss += acc[es][ns][r] * acc[es][ns][r];
    ss += __shfl_xor(ss, 16);
    ss += __shfl_xor(ss, 32);
    const float rs = rsqrtf(ss * (1.f / 128.f) + 1e-6f);
    const size_t t = (size_t)b * 4096 + c * 128 + 32 * w + 16 * ns + li;
#pragma unroll
    for (int es = 0; es < 8; ++es) {
      const int e = es * 16 + g * 4;
      const u32x2 gu = *(const u32x2*)(RG + t * 512 + hd * 128 + e);
      const float gv[4] = {bf_lo(gu.x), bf_hi(gu.x), bf_lo(gu.y), bf_hi(gu.y)};
      float o[4];
#pragma unroll
      for (int r = 0; r < 4; ++r) {
        const float sg = gv[r] / (1.f + __expf(-gv[r]));
        o[r] = acc[es][ns][r] * rs * sg;
      }
      u32x2 v;
      v.x = pk_bf16(o[0], o[1]);
      v.y = pk_bf16(o[2], o[3]);
      *(u32x2*)(ao + t * 1024 + 512 + hd * 128 + e) = v;
    }
  }
}

#define CSWAP(a, b) { unsigned _h = (a) > (b) ? (a) : (b); unsigned _l = (a) > (b) ? (b) : (a); (a) = _h; (b) = _l; }

__device__ void peer_token(const P& p, int layer, int tok, bool dry, char* smem) {
  char* ws = opaque(p.ws);
  const int tid_ = otid(); const int lane = tid_ & 63, li = lane & 15, rw = lane >> 4, rbase = lane & 48;
  const bf16_t* sc = (const bf16_t*)(ws + OFF_R + R_SC_BYTES) + (size_t)tok * 2048;
  unsigned res[4];
#pragma unroll
  for (int pp = 0; pp < 4; ++pp) {
    const int head = 4 * (pp >> 1) + rw, half = pp & 1, hp = head * 2 + half;
    const u32x4 a0 = *(const u32x4*)(sc + hp * 128 + li * 8);
    unsigned k[8];
    const float vv[8] = {bf_lo(a0.x), bf_hi(a0.x), bf_lo(a0.y), bf_hi(a0.y), bf_lo(a0.z), bf_hi(a0.z), bf_lo(a0.w), bf_hi(a0.w)};
#pragma unroll
    for (int e = 0; e < 8; ++e) k[e] = (f_ord(vv[e]) & ~0x7Fu) | (unsigned)(127 - (li * 8 + e));
    CSWAP(k[0], k[1]) CSWAP(k[2], k[3]) CSWAP(k[4], k[5]) CSWAP(k[6], k[7])
    CSWAP(k[0], k[2]) CSWAP(k[1], k[3]) CSWAP(k[4], k[6]) CSWAP(k[5], k[7])
    CSWAP(k[1], k[2]) CSWAP(k[5], k[6])
    CSWAP(k[0], k[4]) CSWAP(k[1], k[5]) CSWAP(k[2], k[6]) CSWAP(k[3], k[7])
    CSWAP(k[2], k[4]) CSWAP(k[3], k[5])
    CSWAP(k[1], k[2]) CSWAP(k[3], k[4]) CSWAP(k[5], k[6])
    unsigned keep = 0;
#pragma unroll
    for (int rd = 0; rd < 16; ++rd) {
      const unsigned wk = rowmax_u(k[0]);
      if (li == rd) keep = wk;
      const bool win = (k[0] == wk);
      k[0] = win ? k[1] : k[0]; k[1] = win ? k[2] : k[1]; k[2] = win ? k[3] : k[2]; k[3] = win ? k[4] : k[3];
      k[4] = win ? k[5] : k[4]; k[5] = win ? k[6] : k[5]; k[6] = win ? k[7] : k[6]; k[7] = win ? 0u : k[7];
    }
    res[pp] = keep;
  }
  int eidx[2];
  float gate[2];
#pragma unroll
  for (int hp2 = 0; hp2 < 2; ++hp2) {
    const unsigned k1 = res[hp2 * 2], k2 = res[hp2 * 2 + 1];
    const float s1 = f_deord(k1 & ~0x7Fu), s2 = f_deord(k2 & ~0x7Fu);
    const int i1 = 127 - (int)(k1 & 0x7Fu), i2 = 127 - (int)(k2 & 0x7Fu);
    int ptr = 0;
    unsigned keep = 0;
    float s2p = __uint_as_float((unsigned)__builtin_amdgcn_ds_bpermute((rbase + 0) * 4, (int)__float_as_uint(s2)));
    unsigned hk = (f_ord(s1 + s2p) & ~0xFFu) | (unsigned)(255 - (li * 16 + 0));
#pragma unroll
    for (int rd = 0; rd < 16; ++rd) {
      const unsigned wk = rowmax_u(hk);
      if (li == rd) keep = wk;
      const bool win = (hk == wk);
      ptr += win ? 1 : 0;
      const int pcl = ptr < 15 ? ptr : 15;
      s2p = __uint_as_float((unsigned)__builtin_amdgcn_ds_bpermute((rbase + pcl) * 4, (int)__float_as_uint(s2)));
      const unsigned nk = (f_ord(s1 + s2p) & ~0xFFu) | (unsigned)(255 - (li * 16 + pcl));
      hk = win ? (ptr < 16 ? nk : 0u) : hk;
    }
    const float ts = f_deord(keep & ~0xFFu);
    const int idx8 = 255 - (int)(keep & 0xFFu);
    const int a = idx8 >> 4, bq = idx8 & 15;
    const int e1 = __builtin_amdgcn_ds_bpermute((rbase + a) * 4, i1);
    const int e2 = __builtin_amdgcn_ds_bpermute((rbase + bq) * 4, i2);
    eidx[hp2] = e1 * 128 + e2;
    const float tmax = f_deord(rowmax_u(keep) & ~0xFFu);
    const float ex = __expf(ts - tmax);
    const float sm = rowsum_f(ex);
    gate[hp2] = ex / sm;
  }
  const unsigned char* xn8 = (const unsigned char*)(ws + OFF_AO) + (32ull << 20) + (size_t)tok * 1024;
  i32x8 tq[8];
#pragma unroll
  for (int s8 = 0; s8 < 8; ++s8) {
    const u32x4 lo = *(const u32x4*)(xn8 + s8 * 128 + rw * 16);
    const u32x4 hi = *(const u32x4*)(xn8 + s8 * 128 + 64 + rw * 16);
    tq[s8] = (i32x8){(int)lo.x, (int)lo.y, (int)lo.z, (int)lo.w, (int)hi.x, (int)hi.y, (int)hi.z, (int)hi.w};
  }
  const unsigned char* U4 = (const unsigned char*)(ws + OFF_U) + (size_t)layer * 16384 * 512;
  const unsigned char* V4 = (const unsigned char*)(ws + OFF_U) + (size_t)(4 + layer) * 16384 * 512;
  const float* SU = (const float*)(ws + OFF_V) + (size_t)layer * 16384;
  const float* SV = (const float*)(ws + OFF_V) + (size_t)(4 + layer) * 16384;
  char* lw = smem + (tid_ >> 6) * 8704;
  float wreg[2];
#pragma unroll
  for (int h2 = 0; h2 < 2; ++h2) {
    const float su = SU[eidx[h2]], sv = SV[eidx[h2]];
    float hreg = 0.f;
    for (int b2 = 0; b2 < 2; ++b2) {
      u32x2 uu[32];
#pragma unroll
      for (int q = 0; q < 32; ++q) {
        const int e = __builtin_amdgcn_readlane(eidx[h2], b2 * 32 + q);
        uu[q] = ((const u32x2*)(U4 + (size_t)e * 512))[lane];
      }
#pragma unroll
      for (int hh = 0; hh < 2; ++hh) {
#pragma unroll
        for (int q = 0; q < 16; ++q) *(u32x2*)(lw + q * 544 + lane * 8) = uu[hh * 16 + q];
        f32x4 acc = {0.f, 0.f, 0.f, 0.f};
#pragma unroll
        for (int s8 = 0; s8 < 8; ++s8) {
          const u32x4 a = *(const u32x4*)(lw + li * 544 + s8 * 64 + rw * 16);
          const i32x8 av = {(int)a.x, (int)a.y, (int)a.z, (int)a.w, 0, 0, 0, 0};
          acc = __builtin_amdgcn_mfma_scale_f32_16x16x128_f8f6f4(av, tq[s8], acc, 4, 0, 0, 0x7f7f7f7f, 0, 0x7f7f7f7f);
        }
        const int lr2 = li & 3;
        const float sel = lr2 == 0 ? acc[0] : lr2 == 1 ? acc[1] : lr2 == 2 ? acc[2] : acc[3];
        const float val = __uint_as_float((unsigned)__builtin_amdgcn_ds_bpermute(((li >> 2) * 16 + li) * 4, (int)__float_as_uint(sel)));
        hreg = (rw == b2 * 2 + hh) ? val : hreg;
      }
    }
    const float hid = hreg * su;
    const float ge = 0.5f * hid * (1.f + erff(hid * 0.70710678118654752f));
    wreg[h2] = gate[h2] * ge * sv;
  }
  f32x2 oa2[8];
#pragma unroll
  for (int e = 0; e < 8; ++e) oa2[e] = (f32x2){0.f, 0.f};
#pragma unroll
  for (int h2 = 0; h2 < 2; ++h2) {
    for (int jb = 0; jb < 64; jb += 32) {
      u32x2 vv[32];
#pragma unroll
      for (int q = 0; q < 32; ++q) {
        const int e = __builtin_amdgcn_readlane(eidx[h2], jb + q);
        vv[q] = ((const u32x2*)(V4 + (size_t)e * 512))[lane];
      }
#pragma unroll
      for (int q = 0; q < 32; ++q) {
        const float wq = rdlane_f(wreg[h2], jb + q);
        const f32x2 w2 = {wq, wq};
#pragma unroll
        for (int k = 0; k < 2; ++k) {
          oa2[4 * k + 0] += w2 * __builtin_amdgcn_cvt_scalef32_pk_f32_fp4(vv[q][k], 1.0f, 0);
          oa2[4 * k + 1] += w2 * __builtin_amdgcn_cvt_scalef32_pk_f32_fp4(vv[q][k], 1.0f, 1);
          oa2[4 * k + 2] += w2 * __builtin_amdgcn_cvt_scalef32_pk_f32_fp4(vv[q][k], 1.0f, 2);
          oa2[4 * k + 3] += w2 * __builtin_amdgcn_cvt_scalef32_pk_f32_fp4(vv[q][k], 1.0f, 3);
        }
      }
    }
  }
  float* hrow = (float*)(ws + OFF_H) + (size_t)tok * 1024;
  float hv[16];
#pragma unroll
  for (int k = 0; k < 4; ++k) {
    const f32x4 h4 = ((const f32x4*)hrow)[lane * 4 + k];
    hv[4 * k] = h4.x; hv[4 * k + 1] = h4.y; hv[4 * k + 2] = h4.z; hv[4 * k + 3] = h4.w;
  }
  float ss = 0.f;
#pragma unroll
  for (int e = 0; e < 8; ++e) {
    hv[2 * e] += oa2[e].x;
    hv[2 * e + 1] += oa2[e].y;
  }
#pragma unroll
  for (int e = 0; e < 16; ++e) ss += hv[e] * hv[e];
  ss = wavesum_f(ss);
  if (dry) { if (lane == 0) ((float*)(ws + OFF_S))[tok] = ss; return; }
  const float rs = rsqrtf(ss * (1.f / 1024.f) + 1e-6f);
  const float* gw = (layer < 3) ? (p.norm_mix + (size_t)(layer + 1) * 1024) : p.final_norm;
  float y[16];
#pragma unroll
  for (int k = 0; k < 4; ++k) {
    const f32x4 g4 = ((const f32x4*)gw)[lane * 4 + k];
    y[4 * k] = hv[4 * k] * rs * g4.x; y[4 * k + 1] = hv[4 * k + 1] * rs * g4.y;
    y[4 * k + 2] = hv[4 * k + 2] * rs * g4.z; y[4 * k + 3] = hv[4 * k + 3] * rs * g4.w;
  }
  if (layer < 3) {
#pragma unroll
    for (int k = 0; k < 4; ++k) ((f32x4*)hrow)[lane * 4 + k] = MAKEF4(hv[4 * k], hv[4 * k + 1], hv[4 * k + 2], hv[4 * k + 3]);
    bf16_t* xo = (bf16_t*)(ws + OFF_XN) + (size_t)tok * 1024;
    u32x4 o0, o1;
    o0.x = pk_bf16(y[0], y[1]); o0.y = pk_bf16(y[2], y[3]); o0.z = pk_bf16(y[4], y[5]); o0.w = pk_bf16(y[6], y[7]);
    o1.x = pk_bf16(y[8], y[9]); o1.y = pk_bf16(y[10], y[11]); o1.z = pk_bf16(y[12], y[13]); o1.w = pk_bf16(y[14], y[15]);
    ((u32x4*)xo)[lane * 2] = o0;
    ((u32x4*)xo)[lane * 2 + 1] = o1;
  } else {
    float* orow = p.out + (size_t)tok * 1024;
#pragma unroll
    for (int k = 0; k < 4; ++k) ((f32x4*)orow)[lane * 4 + k] = MAKEF4(y[4 * k], y[4 * k + 1], y[4 * k + 2], y[4 * k + 3]);
  }
}

__device__ void quant_rows(const float* src, unsigned char* dst, float* scales, int row_begin, int nrows) {
  const int tid_ = otid();
  const int lane = tid_ & 63, w = tid_ >> 6;
  for (int row = row_begin + blockIdx.x * 4 + w; row < nrows; row += gridDim.x * 4) {
    const f32x4* sp = (const f32x4*)(src + (size_t)row * 1024) + lane * 4;
    f32x4 v[4];
    float am = 0.f;
#pragma unroll
    for (int k = 0; k < 4; ++k) {
      v[k] = sp[k];
      am = fmaxf(am, fmaxf(fmaxf(fabsf(v[k].x), fabsf(v[k].y)), fmaxf(fabsf(v[k].z), fabsf(v[k].w))));
    }
    am = fmaxf(am, __shfl_xor(am, 1)); am = fmaxf(am, __shfl_xor(am, 2)); am = fmaxf(am, __shfl_xor(am, 4));
    am = fmaxf(am, __shfl_xor(am, 8)); am = fmaxf(am, __shfl_xor(am, 16)); am = fmaxf(am, __shfl_xor(am, 32));
    const float sc = am > 0.f ? 6.f / am : 1.f;
    u32x2 o;
#pragma unroll
    for (int k = 0; k < 2; ++k) {
      unsigned wd = 0u;
      wd = __builtin_amdgcn_cvt_scalef32_pk_fp4_f32(wd, v[2 * k].x * sc, v[2 * k].y * sc, 1.0f, 0);
      wd = __builtin_amdgcn_cvt_scalef32_pk_fp4_f32(wd, v[2 * k].z * sc, v[2 * k].w * sc, 1.0f, 1);
      wd = __builtin_amdgcn_cvt_scalef32_pk_fp4_f32(wd, v[2 * k + 1].x * sc, v[2 * k + 1].y * sc, 1.0f, 2);
      wd = __builtin_amdgcn_cvt_scalef32_pk_fp4_f32(wd, v[2 * k + 1].z * sc, v[2 * k + 1].w * sc, 1.0f, 3);
      o[k] = wd;
    }
    ((u32x2*)(dst + (size_t)row * 512))[lane] = o;
    if (lane == 0) scales[row] = am > 0.f ? am * (1.f / 6.f) : 1.f;
  }
}

__global__ void __launch_bounds__(256, 2) fwd_kernel(P p) {
  __shared__ __attribute__((aligned(16))) char smem[65536];
  cg::grid_group grid = cg::this_grid();
  char* ws = opaque(p.ws);
  XB xb;
  xb.bar = (unsigned*)(ws + OFF_BAR);
  xb.x = (unsigned)__builtin_amdgcn_s_getreg((3 << 11) | 20) & 0xFu;
  xb.nloc = 0u; xb.nx = 0u;
  if (threadIdx.x == 0) (void)xb_add(&xb.bar[XB_XCNT(xb.x)], 1u);
  const int tid = threadIdx.x;
  const int G = gridDim.x;

  if (STOP == 0) { grid.sync(); return; }
  tr_cvt_tiles(p.even_w_in, (bf16_t*)(ws + OFF_WEIN), 1024, 3584, 2, smem);
  tr_cvt_tiles(p.even_w_out, (bf16_t*)(ws + OFF_WEOUT), 1024, 1024, 2, smem);
  tr_cvt_tiles(p.odd_w_in, (bf16_t*)(ws + OFF_WOIN), 1024, 3072, 2, smem);
  tr_cvt_tiles(p.odd_w_out, (bf16_t*)(ws + OFF_WOOUT), 1024, 1024, 2, smem);
  cvt_straight(p.peer_w_q, (bf16_t*)(ws + OFF_AO), 4ull * 1024 * 2048);
  if (STOP == -1) { grid.sync(); return; }
  cvt_straight(p.peer_sub_keys, (bf16_t*)(ws + OFF_SUBK), 4ull * 8 * 2 * 128 * 128);
  quant_rows(p.peer_u, (unsigned char*)(ws + OFF_U), (float*)(ws + OFF_V), 0, 16384);
  quant_rows(p.peer_v, (unsigned char*)(ws + OFF_U) + 4ull * 16384 * 512, (float*)(ws + OFF_V) + 65536, 0, 16384);
  if (STOP == -2) { grid.sync(); return; }
  {
    float* ctab = (float*)(ws + OFF_COS);
    float* stab = (float*)(ws + OFF_SIN);
    for (int i = blockIdx.x * 256 + tid; i < 4096 * 64; i += G * 256) {
      const int s = i >> 6, d = i & 63;
      const float inv = (float)exp2(-(double)d * (13.287712379549449 / 64.0));
      const float ang = (float)s * inv;
      const double ad = (double)ang;
      const double kq = rint(ad * 0.15915494309189535);
      const float rr = (float)(ad - kq * 6.283185307179586);
      ctab[i] = __cosf(rr);
      stab[i] = __sinf(rr);
    }
  }
  if (STOP == -3) { grid.sync(); return; }
  rmsnorm_rows(p.x, p.norm_mix, (bf16_t*)(ws + OFF_XN), (float*)(ws + OFF_H));
  if (p.out == nullptr) grid.sync();
  gbar(xb);
  if (STOP == 1) return;

  for (int layer = 0; layer < 4; ++layer) {
    const int li2 = layer >> 1;
    ws = opaque(p.ws);
    const int tid = otid();
    const bf16_t* XN = (const bf16_t*)(ws + OFF_XN);
    float* H = (float*)(ws + OFF_H);
    if ((layer & 1) == 0) {
      for (int rep = 0; rep < REP_A; ++rep)
      for (int it = blockIdx.x; it < 64 * 28; it += G) even_in_tile(p, li2, (it & 7) * 8 + (it >> 3) / 28, (it >> 3) % 28, smem);
      if (layer == 0) {
        for (int it = blockIdx.x; it < 512; it += G) {
          const int lf = it >> 7, hp = (it >> 3) & 15, kc = it & 7;
          gemm_tile_fp8out<4>((const bf16_t*)(ws + OFF_SUBK) + ((size_t)lf * 16 + hp) * 16384, 128,
                              (const bf16_t*)(ws + OFF_AO) + (size_t)lf * 1024 * 2048 + (size_t)(kc * 128) * 2048 + hp * 128, 2048, 128,
                              (unsigned char*)(ws + OFF_WPQ) + ((size_t)lf * 2048 + hp * 128) * 1024 + kc * 128, 1024, 256.f, smem);
        }
      }
      gbar(xb);
      if (STOP == 2) return;
      const int qb = (layer == 0) ? 16384 : 49152, qe = (layer == 0) ? 49152 : 65536;
      if ((blockIdx.x & 256) == 0) {
        quant_rows(p.peer_u, (unsigned char*)(ws + OFF_U), (float*)(ws + OFF_V), qb, qe);
        quant_rows(p.peer_v, (unsigned char*)(ws + OFF_U) + 4ull * 16384 * 512, (float*)(ws + OFF_V) + 65536, qb, qe);
      }
      for (int rep = 0; rep < REP_B1; ++rep)
      for (int it = blockIdx.x; it < 1024 + 512; it += G) {
        if (it < 1024) {
          const int x = it >> 4, bh = it & 15;
          const int qt = (x < 32) ? (63 - x) : (x - 32);
          moba_item(p, bh, qt, smem);
        } else {
          const int idx = it - 1024, bh = idx >> 5, c = idx & 31;
          const bf16_t* Rb = (const bf16_t*)(ws + OFF_R);
          gemm_tile_f32<false, 4>(Rb + R_RVT + (size_t)bh * 128 * 4096 + c * 128, 4096,
                               Rb + R_RKT + (size_t)bh * 128 * 4096 + c * 128, 4096, 128,
                               (float*)(ws + OFF_S) + (size_t)idx * 16384, 128, smem);
        }
      }
      if ((blockIdx.x & 256) != 0) {
        quant_rows(p.peer_u, (unsigned char*)(ws + OFF_U), (float*)(ws + OFF_V), qb, qe);
        quant_rows(p.peer_v, (unsigned char*)(ws + OFF_U) + 4ull * 16384 * 512, (float*)(ws + OFF_V) + 65536, qb, qe);
      }
      gbar(xb);
      if (STOP == 3) return;
      {
        const float* S = (const float*)(ws + OFF_S);
        bf16_t* ST = (bf16_t*)(ws + OFF_ST);
        for (int i = blockIdx.x * 256 + tid; i < 16 * 16384 / 4; i += G * 256) {
          const int bh = i >> 12, off = (i & 4095) * 4;
          const float gc = exp2f(128.f * LOG2G[bh & 3]);
          f32x4 st = {0.f, 0.f, 0.f, 0.f};
          const float* Sp = S + (size_t)(bh * 32) * 16384 + off;
          bf16_t* Tp = ST + (size_t)(bh * 32) * 16384 + off;
          for (int c0 = 0; c0 < 32; c0 += 8) {
            f32x4 a[8];
#pragma unroll
            for (int c = 0; c < 8; ++c) a[c] = *(const f32x4*)(Sp + (size_t)(c0 + c) * 16384);
#pragma unroll
            for (int c = 0; c < 8; ++c) {
              u32x2 o;
              o.x = pk_bf16(st[0], st[1]); o.y = pk_bf16(st[2], st[3]);
              *(u32x2*)(Tp + (size_t)(c0 + c) * 16384) = o;
              st = st * gc + a[c];
            }
          }
        }
      }
      gbar(xb);
      if (STOP == 4) return;
      for (int rep = 0; rep < REP_B3; ++rep)
      for (int it = blockIdx.x; it < 512; it += G) ret_out_item(p, it >> 5, it & 31);
      gbar(xb);
      if (STOP == 5) return;
      for (int it = blockIdx.x; it < 64 * 8; it += G) {
        const int tm = (it & 7) * 8 + ((it >> 3) >> 3), tn = (it >> 3) & 7;
        gemm_tile_f32<true, 8>((const bf16_t*)(ws + OFF_AO) + (size_t)tm * 256 * 1024, 1024,
                            (const bf16_t*)(ws + OFF_WEOUT) + ((size_t)li2 * 1024 + tn * 128) * 1024, 1024, 1024,
                            H + (size_t)tm * 256 * 1024 + tn * 128, 1024, smem);
      }
      gbar(xb);
      if (STOP == 6) return;
    } else {
      bf16_t* PR = (bf16_t*)(ws + OFF_R);
      for (int it = blockIdx.x; it < 64 * 24; it += G) {
        const int tm = (it & 7) * 8 + (it >> 3) / 24, tn = (it >> 3) % 24;
        gemm_tile_bf16<8>(XN + (size_t)tm * 256 * 1024, 1024,
                       (const bf16_t*)(ws + OFF_WOIN) + ((size_t)li2 * 3072 + tn * 128) * 1024, 1024, 1024,
                       PR + (size_t)tm * 256 * 3072 + tn * 128, 3072, smem);
      }
      gbar(xb);
      if (STOP == 11) return;
      {
        bf16_t* AO = (bf16_t*)(ws + OFF_AO);
        const float* cw = p.odd_conv + (size_t)li2 * 3 * 1024;
        for (int i = blockIdx.x * 256 + tid; i < T_TOK * 128; i += G * 256) {
          const int t = i >> 7, c8 = (i & 127) * 8;
          const int s = t & 4095;
          const bf16_t* row = PR + (size_t)t * 3072;
          const u32x4 bg = *(const u32x4*)(row + c8);
          float u[3][8];
#pragma unroll
          for (int dt = 0; dt < 3; ++dt) {
            if (s - dt >= 0) {
              const u32x4 cg4 = *(const u32x4*)(row - (size_t)dt * 3072 + 1024 + c8);
              const u32x4 hx4 = *(const u32x4*)(row - (size_t)dt * 3072 + 2048 + c8);
              u[dt][0] = bf_lo(cg4.x) * bf_lo(hx4.x); u[dt][1] = bf_hi(cg4.x) * bf_hi(hx4.x);
              u[dt][2] = bf_lo(cg4.y) * bf_lo(hx4.y); u[dt][3] = bf_hi(cg4.y) * bf_hi(hx4.y);
              u[dt][4] = bf_lo(cg4.z) * bf_lo(hx4.z); u[dt][5] = bf_hi(cg4.z) * bf_hi(hx4.z);
              u[dt][6] = bf_lo(cg4.w) * bf_lo(hx4.w); u[dt][7] = bf_hi(cg4.w) * bf_hi(hx4.w);
            } else {
#pragma unroll
              for (int e = 0; e < 8; ++e) u[dt][e] = 0.f;
            }
          }
          const float bgf[8] = {bf_lo(bg.x), bf_hi(bg.x), bf_lo(bg.y), bf_hi(bg.y), bf_lo(bg.z), bf_hi(bg.z), bf_lo(bg.w), bf_hi(bg.w)};
          float y[8];
#pragma unroll
          for (int e = 0; e < 8; ++e) {
            const float w0 = cw[c8 + e], w1 = cw[1024 + c8 + e], w2 = cw[2048 + c8 + e];
            y[e] = bgf[e] * (w0 * u[2][e] + w1 * u[1][e] + w2 * u[0][e]);
          }
          u32x4 o;
          o.x = pk_bf16(y[0], y[1]); o.y = pk_bf16(y[2], y[3]); o.z = pk_bf16(y[4], y[5]); o.w = pk_bf16(y[6], y[7]);
          *(u32x4*)(AO + (size_t)t * 1024 + c8) = o;
        }
      }
      gbar(xb);
      if (STOP == 12) return;
      for (int it = blockIdx.x; it < 64 * 8; it += G) {
        const int tm = (it & 7) * 8 + ((it >> 3) >> 3), tn = (it >> 3) & 7;
        gemm_tile_f32<true, 8>((const bf16_t*)(ws + OFF_AO) + (size_t)tm * 256 * 1024, 1024,
                            (const bf16_t*)(ws + OFF_WOOUT) + ((size_t)li2 * 1024 + tn * 128) * 1024, 1024, 1024,
                            H + (size_t)tm * 256 * 1024 + tn * 128, 1024, smem);
      }
      gbar(xb);
      if (STOP == 13) return;
    }
    rmsnorm_rows(H, p.norm_ffn + (size_t)layer * 1024, nullptr, nullptr, (unsigned char*)(ws + OFF_AO) + (32ull << 20));
    gbar(xb);
      if (STOP == 7) return;
    {
      bf16_t* SCB = (bf16_t*)(ws + OFF_R + R_SC_BYTES);
      for (int rep = 0; rep < REP_E; ++rep)
      for (int it = blockIdx.x; it < 64 * 16; it += G) {
        const int tm = (it & 7) * 8 + ((it >> 3) >> 4), tn = (it >> 3) & 15;
        gemm_tile_bf16<8, true>((const bf16_t*)(ws + OFF_AO + (32ull << 20)) + (size_t)tm * 256 * 512, 512,
                       (const bf16_t*)(ws + OFF_WPQ) + ((size_t)layer * 2048 + tn * 128) * 512, 512, 512,
                       SCB + (size_t)tm * 256 * 2048 + tn * 128, 2048, smem);
      }
      gbar(xb);
      if (STOP == 8) return;
    }
    for (int rep = 0; rep < REP_F; ++rep)
    for (int it = blockIdx.x; it < T_TOK / 4; it += G) peer_token(p, layer, it * 4 + (otid() >> 6), rep + 1 < REP_F, smem);
    gbar(xb);
      if (STOP == 10) return;
  }
}

extern "C" void kernel_launch(void* const* d_in, const int* in_sizes, int n_in, void* d_out, int out_size, void* d_ws,
                              size_t ws_size, hipStream_t stream) {
  static int grid_blocks = 0;
  if (!grid_blocks) {
    int dev = 0, cus = 0, per_cu = 0;
    hipGetDevice(&dev);
    hipDeviceGetAttribute(&cus, hipDeviceAttributeMultiprocessorCount, dev);
    hipOccupancyMaxActiveBlocksPerMultiprocessor(&per_cu, fwd_kernel, 256, 0);
    if (per_cu > 2) per_cu = 2;
    grid_blocks = cus * per_cu;
  }
  if (ws_size < WS_NEED) {
    fprintf(stderr, "workspace too small: %zu < %zu\n", ws_size, (size_t)WS_NEED);
    return;
  }
  P p{};
  p.x = (const float*)d_in[0];
  p.norm_mix = (const float*)d_in[1];
  p.norm_ffn = (const float*)d_in[2];
  p.even_w_in = (const float*)d_in[3];
  p.even_w_out = (const float*)d_in[4];
  p.odd_w_in = (const float*)d_in[5];
  p.odd_conv = (const float*)d_in[6];
  p.odd_w_out = (const float*)d_in[7];
  p.peer_w_q = (const float*)d_in[8];
  p.peer_sub_keys = (const float*)d_in[9];
  p.peer_u = (const float*)d_in[10];
  p.peer_v = (const float*)d_in[11];
  p.final_norm = (const float*)d_in[12];
  p.out = (float*)d_out;
  p.ws = (char*)d_ws;
  (void)hipMemsetAsync(d_ws, 0, 16384, stream);
  void* args[] = {&p};
  hipError_t e = hipLaunchCooperativeKernel((void*)fwd_kernel, dim3(grid_blocks), dim3(256), args, 0, stream);
  if (e != hipSuccess) {
    fprintf(stderr, "cooperative launch failed: %s (grid %d)\n", hipGetErrorString(e), grid_blocks);
    (void)hipGetLastError();
    grid_blocks = 256;
    e = hipLaunchCooperativeKernel((void*)fwd_kernel, dim3(grid_blocks), dim3(256), args, 0, stream);
    if (e != hipSuccess) fprintf(stderr, "cooperative launch failed again: %s\n", hipGetErrorString(e));
  }
}
```

```cpp
#include <hip/hip_runtime.h>
#include <hip/hip_cooperative_groups.h>
#include <cstdio>
namespace cg = cooperative_groups;

typedef unsigned short bf16_t;
typedef short bf16x8 __attribute__((ext_vector_type(8)));
typedef float f32x4 __attribute__((ext_vector_type(4)));
typedef unsigned u32x4 __attribute__((ext_vector_type(4)));
typedef unsigned u32x2 __attribute__((ext_vector_type(2)));
typedef float f32x2 __attribute__((ext_vector_type(2)));
typedef int i32x8 __attribute__((ext_vector_type(8)));
__device__ __forceinline__ f32x4 MAKEF4(float a, float b, float c, float d) { f32x4 r = {a, b, c, d}; return r; }

#ifndef STOP
#define STOP 99
#endif
#ifndef REP_E
#define REP_E 1
#endif
#ifndef REP_B1
#define REP_B1 1
#endif
#ifndef REP_A
#define REP_A 1
#endif
#ifndef REP_B3
#define REP_B3 1
#endif
#ifndef REP_F
#define REP_F 1
#endif
#define T_TOK 16384
#define DM 1024
#define SEQL 4096

constexpr size_t OFF_BAR   = 0;
constexpr size_t OFF_COS   = 16384;
constexpr size_t OFF_SIN   = OFF_COS + 4096ull * 64 * 4;
constexpr size_t OFF_KPART = OFF_SIN + 4096ull * 64 * 4;
constexpr size_t OFF_WEIN  = OFF_KPART + 256ull * 4 * 128 * 4;
constexpr size_t OFF_WEOUT = OFF_WEIN + 2ull * 3584 * 1024 * 2;
constexpr size_t OFF_WOIN  = OFF_WEOUT + 2ull * 1024 * 2048 * 2;
constexpr size_t OFF_WOOUT = OFF_WOIN + 2ull * 3072 * 1024 * 2;
constexpr size_t OFF_WPQ   = OFF_WOOUT + 2ull * 1024 * 1024 * 2;
constexpr size_t OFF_SUBK  = OFF_WPQ + 4ull * 2048 * 1024 * 2;
constexpr size_t OFF_U     = OFF_SUBK + 4ull * 8 * 2 * 128 * 128 * 2;
constexpr size_t OFF_V     = OFF_U + 4ull * 16384 * 1024 * 2;
constexpr size_t OFF_H     = OFF_V + 4ull * 16384 * 1024 * 2;
constexpr size_t OFF_XN    = OFF_H + 16384ull * 1024 * 4;
constexpr size_t OFF_R     = OFF_XN + 16384ull * 1024 * 2;
constexpr size_t R_BYTES   = 192ull << 20;
constexpr size_t OFF_AO    = OFF_R + R_BYTES;
constexpr size_t OFF_S     = OFF_AO + 16384ull * 2048 * 2;
constexpr size_t OFF_ST    = OFF_S + 16ull * 32 * 128 * 128 * 4;
constexpr size_t WS_NEED   = OFF_ST + 16ull * 32 * 128 * 128 * 2;
constexpr size_t HEADBUF = 16ull * 4096 * 128;
constexpr size_t R_MQ = 0, R_MK = HEADBUF, R_MVT = 2 * HEADBUF, R_RQ = 3 * HEADBUF, R_RK = 4 * HEADBUF,
                 R_RKT = 5 * HEADBUF, R_RVT = 6 * HEADBUF, R_RG = 7 * HEADBUF;
constexpr size_t R_SC_BYTES = 64ull << 20;

struct P {
  const float *x, *norm_mix, *norm_ffn, *even_w_in, *even_w_out, *odd_w_in, *odd_conv, *odd_w_out,
      *peer_w_q, *peer_sub_keys, *peer_u, *peer_v, *final_norm;
  float* out;
  char* ws;
};

__device__ __forceinline__ int otid() { int t = threadIdx.x; asm volatile("" : "+v"(t)); return t; }
typedef __attribute__((address_space(1))) char gchar_t;
__device__ __forceinline__ char* opaque(char* q) { size_t z = 0; asm volatile("" : "+s"(z)); return q + z; }
typedef __bf16 bf16x2_t __attribute__((ext_vector_type(2)));
__device__ __forceinline__ unsigned pk_bf16(float lo, float hi) {
  bf16x2_t v = {(__bf16)lo, (__bf16)hi};
  return __builtin_bit_cast(unsigned, v);
}
__device__ __forceinline__ bf16_t f2bf(float f) { return (bf16_t)(pk_bf16(f, 0.f) & 0xffffu); }
__device__ __forceinline__ float bf_lo(unsigned u) { return __uint_as_float(u << 16); }
__device__ __forceinline__ float bf_hi(unsigned u) { return __uint_as_float(u & 0xffff0000u); }
__device__ __forceinline__ float bf2f(bf16_t h) { return __uint_as_float(((unsigned)h) << 16); }

template <int CTRL>
__device__ __forceinline__ unsigned dpp_u(unsigned x) {
  return (unsigned)__builtin_amdgcn_update_dpp(0, (int)x, CTRL, 0xF, 0xF, false);
}
__device__ __forceinline__ unsigned rowmax_u(unsigned x) {
  unsigned y;
  y = dpp_u<0x121>(x); x = x > y ? x : y;
  y = dpp_u<0x122>(x); x = x > y ? x : y;
  y = dpp_u<0x124>(x); x = x > y ? x : y;
  y = dpp_u<0x128>(x); x = x > y ? x : y;
  return x;
}
__device__ __forceinline__ float rowsum_f(float x) {
  x += __uint_as_float(dpp_u<0x121>(__float_as_uint(x)));
  x += __uint_as_float(dpp_u<0x122>(__float_as_uint(x)));
  x += __uint_as_float(dpp_u<0x124>(__float_as_uint(x)));
  x += __uint_as_float(dpp_u<0x128>(__float_as_uint(x)));
  return x;
}
__device__ __forceinline__ float rdlane_f(float x, int l) {
  return __uint_as_float((unsigned)__builtin_amdgcn_readlane((int)__float_as_uint(x), l));
}
__device__ __forceinline__ float wavesum_f(float x) {
  x = rowsum_f(x);
  return rdlane_f(x, 0) + rdlane_f(x, 16) + rdlane_f(x, 32) + rdlane_f(x, 48);
}
__device__ __forceinline__ unsigned f_ord(float v) {
  unsigned u = __float_as_uint(v);
  return (u & 0x80000000u) ? ~u : (u | 0x80000000u);
}
__device__ __forceinline__ float f_deord(unsigned u) {
  return __uint_as_float((u & 0x80000000u) ? (u ^ 0x80000000u) : ~u);
}

#define XB_TMO 128
#define XB_XCNT(j) (256 + 64 * (j))
#define XB_XSUB(j) (1280 + 64 * (j))
#define XB_XGEN(j) (2304 + 64 * (j))
#define XB_TOP 3328
#define XB_TOPGEN 3392
#define XB_SPIN_CAP (1u << 22)
__device__ __forceinline__ unsigned xb_ld(unsigned* q) { return __hip_atomic_load(q, __ATOMIC_RELAXED, __HIP_MEMORY_SCOPE_AGENT); }
__device__ __forceinline__ unsigned xb_add(unsigned* q, unsigned v) { return __hip_atomic_fetch_add(q, v, __ATOMIC_RELAXED, __HIP_MEMORY_SCOPE_AGENT); }
#define XB_SPIN(cond, bar) do { unsigned _sp = 0; while (cond) { __builtin_amdgcn_s_sleep(1); \
    if ((++_sp & 255u) == 0u) { if (xb_ld(&(bar)[XB_TMO])) break; if (_sp > XB_SPIN_CAP) { atomicAdd(&(bar)[XB_TMO], 1u); break; } } } } while (0)
struct XB { unsigned* bar; unsigned x, nloc, nx; };
__device__ __forceinline__ void xb_complete(unsigned* bar, unsigned x, unsigned& nloc, unsigned& nx) {
  const unsigned G = gridDim.x;
  unsigned sum, cnt, mine, sp = 0u;
  for (;;) {
    sum = 0u; cnt = 0u; mine = 0u;
#pragma unroll
    for (unsigned j = 0; j < 16; ++j) { const unsigned c = xb_ld(&bar[XB_XCNT(j)]); sum += c; cnt += (c > 0u) ? 1u : 0u; mine = (j == x) ? c : mine; }
    if (sum == G) break;
    __builtin_amdgcn_s_sleep(1);
    if ((++sp & 255u) == 0u) { if (xb_ld(&bar[XB_TMO])) break; if (sp > XB_SPIN_CAP) { atomicAdd(&bar[XB_TMO], 1u); break; } }
  }
  nloc = mine > 0u ? mine : 1u; nx = cnt > 0u ? cnt : 1u;
}
__device__ __forceinline__ void gbar(XB& b) {
  asm volatile("s_waitcnt vmcnt(0) lgkmcnt(0)" ::: "memory");
  __syncthreads();
  if (threadIdx.x == 0) {
    unsigned* bar = b.bar;
    if (b.nloc == 0u) xb_complete(bar, b.x, b.nloc, b.nx);
    const unsigned nloc = b.nloc, nx = b.nx;
    const unsigned old = xb_add(&bar[XB_XSUB(b.x)], 1u);
    const unsigned gen = old / nloc;
    if (old + 1u == (gen + 1u) * nloc) {
      __builtin_amdgcn_fence(__ATOMIC_RELEASE, "agent");
      asm volatile("s_waitcnt vmcnt(0)" ::: "memory");
      const unsigned og = xb_add(&bar[XB_TOP], 1u);
      const unsigned tg = og / nx;
      if (og + 1u == (tg + 1u) * nx) xb_add(&bar[XB_TOPGEN], 1u);
      else XB_SPIN(xb_ld(&bar[XB_TOPGEN]) == tg, bar);
      __builtin_amdgcn_fence(__ATOMIC_ACQUIRE, "agent");
      xb_add(&bar[XB_XGEN(b.x)], 1u);
      asm volatile("s_waitcnt vmcnt(0)" ::: "memory");
    } else {
      XB_SPIN(xb_ld(&bar[XB_XGEN(b.x)]) == gen, bar);
      __builtin_amdgcn_fence(__ATOMIC_ACQUIRE, "agent");
      asm volatile("s_waitcnt vmcnt(0)" ::: "memory");
    }
  }
  __syncthreads();
}

template <int MI, bool SWAP, bool F8 = false>
__device__ __forceinline__ void gemm_core(const bf16_t* __restrict__ A, int lda, const bf16_t* __restrict__ B, int ldb,
                                          int K, char* smem, f32x4 (&acc)[MI][4]) {
  const int tid = otid(), lane = tid & 63, w = tid >> 6, wm = w >> 1, wn = w & 1;
  const int lr = tid >> 3, lc = tid & 7;
  const int li = lane & 15, g = lane >> 4;
  u32x4 ra[MI], rb[4];
  const bf16_t* ap = A + (size_t)lr * lda + lc * 8;
  const bf16_t* bp = B + (size_t)lr * ldb + lc * 8;
#pragma unroll
  for (int i = 0; i < MI; ++i)
#pragma unroll
    for (int j = 0; j < 4; ++j) acc[i][j] = (f32x4){0.f, 0.f, 0.f, 0.f};
  const int nk = K >> 6;
#pragma unroll
  for (int i = 0; i < MI; ++i) ra[i] = *(const u32x4*)(ap + (size_t)(32 * i) * lda);
#pragma unroll
  for (int i = 0; i < 4; ++i) rb[i] = *(const u32x4*)(bp + (size_t)(32 * i) * ldb);
  const int woff = lr * 128 + ((lc ^ (lr & 7)) << 4);
  const int xrow = (wm * 16 * MI + li) * 128;
  const int wrow = 32768 + (wn * 32 + li) * 128;
  for (int kt = 0; kt < nk; ++kt) {
    __syncthreads();
#pragma unroll
    for (int i = 0; i < MI; ++i) *(u32x4*)(smem + woff + i * 4096) = ra[i];
#pragma unroll
    for (int i = 0; i < 4; ++i) *(u32x4*)(smem + 32768 + woff + i * 4096) = rb[i];
    __syncthreads();
    if (kt + 1 < nk) {
#pragma unroll
      for (int i = 0; i < MI; ++i) ra[i] = *(const u32x4*)(ap + (size_t)(32 * i) * lda + (kt + 1) * 64);
#pragma unroll
      for (int i = 0; i < 4; ++i) rb[i] = *(const u32x4*)(bp + (size_t)(32 * i) * ldb + (kt + 1) * 64);
    }
    if (F8) {
      const int c0 = (g ^ (li & 7)) << 4, c1 = ((4 + g) ^ (li & 7)) << 4;
      i32x8 wf8[4];
#pragma unroll
      for (int j = 0; j < 4; ++j) {
        const char* rp = smem + wrow + ((j & 1) * 16 + (j >> 1) * 64) * 128;
        const u32x4 lo = *(const u32x4*)(rp + c0), hi = *(const u32x4*)(rp + c1);
        wf8[j] = (i32x8){(int)lo.x, (int)lo.y, (int)lo.z, (int)lo.w, (int)hi.x, (int)hi.y, (int)hi.z, (int)hi.w};
      }
#pragma unroll
      for (int i = 0; i < MI; ++i) {
        const char* rp = smem + xrow + i * 2048;
        const u32x4 lo = *(const u32x4*)(rp + c0), hi = *(const u32x4*)(rp + c1);
        const i32x8 xf8 = {(int)lo.x, (int)lo.y, (int)lo.z, (int)lo.w, (int)hi.x, (int)hi.y, (int)hi.z, (int)hi.w};
#pragma unroll
        for (int j = 0; j < 4; ++j)
          acc[i][j] = __builtin_amdgcn_mfma_scale_f32_16x16x128_f8f6f4(wf8[j], xf8, acc[i][j], 0, 0, 0, 0x77777777, 0, 0x7f7f7f7f);
      }
    } else {
#pragma unroll
    for (int kk = 0; kk < 2; ++kk) {
      const int ch = ((kk * 4 + g) ^ (li & 7)) << 4;
      bf16x8 xf[MI], wf[4];
#pragma unroll
      for (int j = 0; j < 4; ++j) wf[j] = *(const bf16x8*)(smem + wrow + ((j & 1) * 16 + (j >> 1) * 64) * 128 + ch);
#pragma unroll
      for (int i = 0; i < MI; ++i) xf[i] = *(const bf16x8*)(smem + xrow + i * 2048 + ch);
#pragma unroll
      for (int i = 0; i < MI; ++i)
#pragma unroll
        for (int j = 0; j < 4; ++j) {
          if (SWAP) acc[i][j] = __builtin_amdgcn_mfma_f32_16x16x32_bf16(xf[i], wf[j], acc[i][j], 0, 0, 0);
          else acc[i][j] = __builtin_amdgcn_mfma_f32_16x16x32_bf16(wf[j], xf[i], acc[i][j], 0, 0, 0);
        }
    }
    }
  }
}

#define EPI_COORDS                                                             \
  const int tid_ = otid(); const int lane = tid_ & 63, w = tid_ >> 6, wm = w >> 1, wn = w & 1; \
  const int li = lane & 15, g = lane >> 4;                                     \
  (void)wm; (void)wn; (void)li; (void)g;
#define NCOL(j) (((j) & 1) * 16 + wn * 32 + ((j) >> 1) * 64 + g * 4)
#define MROW(i) (wm * 16 * MI + (i) * 16 + li)
#define NCOLS(j) (((j) & 1) * 16 + wn * 32 + ((j) >> 1) * 64 + li)
#define MROWS(i) (wm * 16 * MI + (i) * 16 + g * 4)

template <int MI, bool F8 = false>
__device__ void gemm_tile_bf16(const bf16_t* A, int lda, const bf16_t* B, int ldb, int K, bf16_t* C, int ldc, char* smem) {
  f32x4 acc[MI][4];
  gemm_core<MI, false, F8>(A, lda, B, ldb, K, smem, acc);
  EPI_COORDS
#pragma unroll
  for (int i = 0; i < MI; ++i)
#pragma unroll
    for (int j = 0; j < 4; ++j) {
      u32x2 v;
      v.x = pk_bf16(acc[i][j][0], acc[i][j][1]);
      v.y = pk_bf16(acc[i][j][2], acc[i][j][3]);
      *(u32x2*)(C + (size_t)MROW(i) * ldc + NCOL(j)) = v;
    }
}
template <int MI>
__device__ void gemm_tile_fp8out(const bf16_t* A, int lda, const bf16_t* B, int ldb, int K, unsigned char* C, int ldc, float mul, char* smem) {
  f32x4 acc[MI][4];
  gemm_core<MI, false>(A, lda, B, ldb, K, smem, acc);
  EPI_COORDS
#pragma unroll
  for (int i = 0; i < MI; ++i)
#pragma unroll
    for (int j = 0; j < 4; ++j) {
      int wd = __builtin_amdgcn_cvt_pk_fp8_f32(acc[i][j][0] * mul, acc[i][j][1] * mul, 0, false);
      wd = __builtin_amdgcn_cvt_pk_fp8_f32(acc[i][j][2] * mul, acc[i][j][3] * mul, wd, true);
      *(int*)(C + (size_t)MROW(i) * ldc + NCOL(j)) = wd;
    }
}
template <bool ACCUM, int MI>
__device__ void gemm_tile_f32(const bf16_t* A, int lda, const bf16_t* B, int ldb, int K, float* C, int ldc, char* smem) {
  f32x4 acc[MI][4];
  gemm_core<MI, false>(A, lda, B, ldb, K, smem, acc);
  EPI_COORDS
#pragma unroll
  for (int i = 0; i < MI; ++i)
#pragma unroll
    for (int j = 0; j < 4; ++j) {
      f32x4* cp = (f32x4*)(C + (size_t)MROW(i) * ldc + NCOL(j));
      f32x4 v = acc[i][j];
      if (ACCUM) v += *cp;
      *cp = v;
    }
}

__device__ __constant__ float LOG2G[4] = {-0.04580368961312479f, -0.02272007650008353f, -0.011315313227834146f,
                                          -0.005646563141142063f};

__device__ void even_in_tile(const P& p, int li_even, int tm, int tn, char* smem) {
  constexpr int MI = 8;
  char* ws = opaque(p.ws);
  const bf16_t* A = (const bf16_t*)(ws + OFF_XN) + (size_t)tm * 256 * 1024;
  const bf16_t* B = (const bf16_t*)(ws + OFF_WEIN) + ((size_t)li_even * 3584 + (size_t)tn * 128) * 1024;
  const int seg = tn >> 2, hd = tn & 3;
  const int t0 = tm * 256, b = t0 >> 12, s0 = t0 & 4095, bh = b * 4 + hd;
  bf16_t* R = (bf16_t*)(ws + OFF_R);
  f32x4 acc[MI][4];
  if (seg == 2 || seg == 5) {
    gemm_core<MI, true>(A, 1024, B, 1024, 1024, smem, acc);
    EPI_COORDS
    bf16_t* dst = R + (seg == 2 ? R_MVT : R_RVT) + (size_t)bh * 128 * 4096;
#pragma unroll
    for (int i = 0; i < MI; ++i)
#pragma unroll
      for (int j = 0; j < 4; ++j) {
        u32x2 v;
        v.x = pk_bf16(acc[i][j][0], acc[i][j][1]);
        v.y = pk_bf16(acc[i][j][2], acc[i][j][3]);
        *(u32x2*)(dst + (size_t)NCOLS(j) * 4096 + s0 + MROWS(i)) = v;
      }
    return;
  }
  gemm_core<MI, false>(A, 1024, B, 1024, 1024, smem, acc);
  EPI_COORDS
  if (seg != 6) {
    const float* ctab = (const float*)(ws + OFF_COS);
    const float* stab = (const float*)(ws + OFF_SIN);
#pragma unroll
    for (int i = 0; i < MI; ++i) {
      const int s = s0 + MROW(i);
#pragma unroll
      for (int jj = 0; jj < 2; ++jj) {
        const int d = wn * 32 + jj * 16 + g * 4;
        const f32x4 c = *(const f32x4*)(ctab + s * 64 + d);
        const f32x4 sn = *(const f32x4*)(stab + s * 64 + d);
#pragma unroll
        for (int r = 0; r < 4; ++r) {
          const float a = acc[i][jj][r], bb = acc[i][jj + 2][r];
          acc[i][jj][r] = a * c[r] - bb * sn[r];
          acc[i][jj + 2][r] = bb * c[r] + a * sn[r];
        }
      }
    }
  }
  if (seg == 1) {
#pragma unroll
    for (int ih = 0; ih < 2; ++ih) {
      float* kp = (float*)(ws + OFF_KPART) + ((size_t)(tm * 4 + wm * 2 + ih) * 4 + hd) * 128;
#pragma unroll
      for (int j = 0; j < 4; ++j)
#pragma unroll
        for (int r = 0; r < 4; ++r) {
          float sm = acc[ih * 4][j][r] + acc[ih * 4 + 1][j][r] + acc[ih * 4 + 2][j][r] + acc[ih * 4 + 3][j][r];
          sm = rowsum_f(sm);
          if (li == 0) kp[NCOL(j) + r] = sm;
        }
    }
  }
  if (seg == 4) {
#pragma unroll
    for (int i = 0; i < MI; ++i)
#pragma unroll
      for (int j = 0; j < 4; ++j) acc[i][j] *= 0.08838834764831843f;
  }
  if (seg != 6) {
    bf16_t* dst = R + (seg == 0 ? R_MQ : seg == 1 ? R_MK : seg == 3 ? R_RQ : R_RK) + (size_t)bh * 4096 * 128;
#pragma unroll
    for (int i = 0; i < MI; ++i)
#pragma unroll
      for (int j = 0; j < 4; ++j) {
        u32x2 v;
        v.x = pk_bf16(acc[i][j][0], acc[i][j][1]);
        v.y = pk_bf16(acc[i][j][2], acc[i][j][3]);
        *(u32x2*)(dst + (size_t)(s0 + MROW(i)) * 128 + NCOL(j)) = v;
      }
  }
  if (seg == 4) {
    bf16_t* dst = R + R_RKT + (size_t)bh * 128 * 4096;
    const float lg = LOG2G[hd];
#pragma unroll
    for (int i = 0; i < MI; ++i) {
      const int s = s0 + MROW(i);
      const float z = exp2f((float)(127 - (s & 127)) * lg);
#pragma unroll
      for (int j = 0; j < 4; ++j)
#pragma unroll
        for (int r = 0; r < 4; ++r) dst[(size_t)(NCOL(j) + r) * 4096 + s] = f2bf(acc[i][j][r] * z);
    }
  }
  if (seg == 6) {
    bf16_t* dst = R + R_RG;
#pragma unroll
    for (int i = 0; i < MI; ++i)
#pragma unroll
      for (int j = 0; j < 4; ++j) {
        u32x2 v;
        v.x = pk_bf16(acc[i][j][0], acc[i][j][1]);
        v.y = pk_bf16(acc[i][j][2], acc[i][j][3]);
        *(u32x2*)(dst + (size_t)(t0 + MROW(i)) * 512 + hd * 128 + NCOL(j)) = v;
      }
  }
}

__device__ void tr_cvt_tiles(const float* src, bf16_t* dst, int K, int N, int nl, char* smem) {
  float(*t)[65] = (float(*)[65])smem;
  const int tk = K >> 6, tnn = N >> 6, per = tk * tnn, total = per * nl;
  const int tid = threadIdx.x;
  for (int it = blockIdx.x; it < total; it += gridDim.x) {
    const int l = it / per, rem = it % per, kt = rem / tnn, nt = rem % tnn;
    const float* s = src + (size_t)l * K * N + (size_t)kt * 64 * N + nt * 64;
    bf16_t* d = dst + (size_t)l * K * N + (size_t)nt * 64 * K + kt * 64;
    __syncthreads();
#pragma unroll
    for (int i = 0; i < 16; ++i) {
      const int e = tid + i * 256, r = e >> 6, c = e & 63;
      t[r][c] = s[(size_t)r * N + c];
    }
    __syncthreads();
#pragma unroll
    for (int i = 0; i < 16; ++i) {
      const int e = tid + i * 256, n = e >> 6, k = e & 63;
      d[(size_t)n * K + k] = f2bf(t[k][n]);
    }
  }
}
__device__ void cvt_straight(const float* src, bf16_t* dst, size_t n) {
  const size_t n4 = n >> 2;
  for (size_t i = (size_t)blockIdx.x * 256 + threadIdx.x; i < n4; i += (size_t)gridDim.x * 256) {
    const f32x4 v = ((const f32x4*)src)[i];
    u32x2 o;
    o.x = pk_bf16(v.x, v.y);
    o.y = pk_bf16(v.z, v.w);
    ((u32x2*)dst)[i] = o;
  }
}
__device__ void rmsnorm_rows(const float* src, const float* gw, bf16_t* dst, float* copy, unsigned char* dst8 = nullptr) {
  const int tid_ = otid(); const int lane = tid_ & 63, w = tid_ >> 6;
  f32x4 gg[4];
#pragma unroll
  for (int k = 0; k < 4; ++k) gg[k] = ((const f32x4*)gw)[lane + 64 * k];
  const int stride = gridDim.x * 4;
  for (int row0 = blockIdx.x * 4 + w; row0 < T_TOK; row0 += stride * 4) {
    f32x4 v[4][4];
#pragma unroll
    for (int rr = 0; rr < 4; ++rr) {
      const int row = row0 + rr * stride;
      if (row < T_TOK) {
        const f32x4* sp = (const f32x4*)(src + (size_t)row * 1024);
#pragma unroll
        for (int k = 0; k < 4; ++k) v[rr][k] = sp[lane + 64 * k];
      }
    }
#pragma unroll
    for (int rr = 0; rr < 4; ++rr) {
      const int row = row0 + rr * stride;
      if (row < T_TOK) {
        float ss = 0.f;
#pragma unroll
        for (int k = 0; k < 4; ++k) ss += v[rr][k].x * v[rr][k].x + v[rr][k].y * v[rr][k].y + v[rr][k].z * v[rr][k].z + v[rr][k].w * v[rr][k].w;
        ss = wavesum_f(ss);
        const float rs = rsqrtf(ss * (1.f / 1024.f) + 1e-6f);
#pragma unroll
        for (int k = 0; k < 4; ++k) {
          const f32x4 y = v[rr][k] * rs * gg[k];
          u32x2 o;
          o.x = pk_bf16(y.x, y.y);
          o.y = pk_bf16(y.z, y.w);
          if (dst) ((u32x2*)(dst + (size_t)row * 1024))[lane + 64 * k] = o;
          if (dst8) {
            int wd = __builtin_amdgcn_cvt_pk_fp8_f32(y.x, y.y, 0, false);
            wd = __builtin_amdgcn_cvt_pk_fp8_f32(y.z, y.w, wd, true);
            ((int*)(dst8 + (size_t)row * 1024))[lane + 64 * k] = wd;
          }
          if (copy) ((f32x4*)(copy + (size_t)row * 1024))[lane + 64 * k] = v[rr][k];
        }
      }
    }
  }
}

__device__ void moba_item(const P& p, int bh, int qt, char* smem) {
  char* ws = opaque(p.ws);
  const bf16_t* R = (const bf16_t*)(ws + OFF_R);
  const bf16_t* Q = R + R_MQ + (size_t)bh * 4096 * 128;
  const bf16_t* Kp = R + R_MK + (size_t)bh * 4096 * 128;
  const bf16_t* VT = R + R_MVT + (size_t)bh * 128 * 4096;
  const int b = bh >> 2, hd = bh & 3;
  const int qblk = qt >> 2, qin = qt & 3;
  const int q0 = qt * 64;
  const int tid = otid(), lane = tid & 63, w = tid >> 6, li = lane & 15, g = lane >> 4;
  char* sK = smem;
  char* sV = smem + 16384;
  float* sGate = (float*)(smem + 32768);
  unsigned* sMask = (unsigned*)(smem + 36864);
  float* sKm = (float*)(smem + 37120);
  __syncthreads();
  {
    const float* kp = (const float*)(ws + OFF_KPART);
    for (int e = tid; e < qblk * 128; e += 256) {
      const int n = e >> 7, d = e & 127;
      float sm = 0.f;
#pragma unroll
      for (int x4 = 0; x4 < 4; ++x4) sm += kp[((size_t)(b * 64 + n * 4 + x4) * 4 + hd) * 128 + d];
      sKm[n * 132 + d] = sm * (1.f / 256.f);
    }
  }
  __syncthreads();
  {
    const int q = tid >> 2, nb = (tid & 3) * 4;
    const u32x4* qp = (const u32x4*)(Q + (size_t)(q0 + q) * 128);
    float gsum[4] = {0.f, 0.f, 0.f, 0.f};
    u32x4 qrow[16];
#pragma unroll
    for (int c = 0; c < 16; ++c) qrow[c] = qp[c];
#pragma unroll
    for (int c = 0; c < 16; ++c) {
      const u32x4 u = qrow[c];
      const float qv[8] = {bf_lo(u.x), bf_hi(u.x), bf_lo(u.y), bf_hi(u.y), bf_lo(u.z), bf_hi(u.z), bf_lo(u.w), bf_hi(u.w)};
#pragma unroll
      for (int nn = 0; nn < 4; ++nn) {
        if (nb + nn < qblk) {
          const float* km = sKm + (nb + nn) * 132 + c * 8;
#pragma unroll
          for (int e = 0; e < 8; ++e) gsum[nn] += qv[e] * km[e];
        }
      }
    }
#pragma unroll
    for (int nn = 0; nn < 4; ++nn) sGate[q * 16 + nb + nn] = gsum[nn];
  }
  __syncthreads();
  if (tid < 64) {
    unsigned m = 0;
    for (int n = 0; n < qblk; ++n) {
      const float gn = sGate[tid * 16 + n];
      int rank = 0;
      for (int mm = 0; mm < qblk; ++mm) {
        const float gm = sGate[tid * 16 + mm];
        rank += (gm > gn || (gm == gn && mm < n)) ? 1 : 0;
      }
      if (rank < 3) m |= 1u << n;
    }
    sMask[tid] = m;
  }
  __syncthreads();
  const unsigned mymask = sMask[w * 16 + li];
  const int qpos = q0 + w * 16 + li;
  bf16x8 qf[4];
#pragma unroll
  for (int kk = 0; kk < 4; ++kk) qf[kk] = *(const bf16x8*)(Q + (size_t)qpos * 128 + (kk * 4 + g) * 8);
  f32x4 oacc[8];
#pragma unroll
  for (int d = 0; d < 8; ++d) oacc[d] = (f32x4){0.f, 0.f, 0.f, 0.f};
  float mrun = -INFINITY, lrun = 0.f;
  const int ntiles = qblk * 4 + qin + 1;
  const int kr = tid >> 4, kc = tid & 15;
  const int vr = tid >> 3, vc = tid & 7;
  u32x4 rkA[4], rvA[4], rkB[4], rvB[4];
#pragma unroll
  for (int i = 0; i < 4; ++i) {
    rkA[i] = *(const u32x4*)(Kp + (size_t)(kr + 16 * i) * 128 + kc * 8);
    rvA[i] = *(const u32x4*)(VT + (size_t)(vr + 32 * i) * 4096 + vc * 8);
  }
  if (ntiles > 1) {
#pragma unroll
    for (int i = 0; i < 4; ++i) {
      rkB[i] = *(const u32x4*)(Kp + (size_t)(64 + kr + 16 * i) * 128 + kc * 8);
      rvB[i] = *(const u32x4*)(VT + (size_t)(vr + 32 * i) * 4096 + 64 + vc * 8);
    }
  }
  const float SC = 0.12751743082459868f;
  auto step = [&](const int tt, u32x4 (&rk)[4], u32x4 (&rv)[4]) __attribute__((always_inline)) {
    __syncthreads();
#pragma unroll
    for (int i = 0; i < 4; ++i) {
      const int row = kr + 16 * i;
      const int f = ((row >> 3) & 3) * 4 + (row & 3);
      *(u32x4*)(sK + row * 256 + ((kc ^ f) << 4)) = rk[i];
      const int vrow = vr + 32 * i;
      *(u32x4*)(sV + vrow * 128 + ((vc ^ (vrow & 7)) << 4)) = rv[i];
    }
    __syncthreads();
    if (tt + 2 < ntiles) {
      const int k1 = (tt + 2) * 64;
#pragma unroll
      for (int i = 0; i < 4; ++i) {
        rk[i] = *(const u32x4*)(Kp + (size_t)(k1 + kr + 16 * i) * 128 + kc * 8);
        rv[i] = *(const u32x4*)(VT + (size_t)(vr + 32 * i) * 4096 + k1 + vc * 8);
      }
    }
    const int blk = tt >> 2;
    const bool own = (blk == qblk);
    const bool rowvalid = own || ((mymask >> blk) & 1u);
    if (__any(rowvalid)) {
      const int key0 = tt * 64;
      f32x4 sacc[2][2];
#pragma unroll
      for (int st = 0; st < 2; ++st)
#pragma unroll
        for (int kt = 0; kt < 2; ++kt) {
          sacc[st][kt] = (f32x4){0.f, 0.f, 0.f, 0.f};
          const int row = 32 * st + 8 * (li >> 2) + 4 * kt + (li & 3);
#pragma unroll
          for (int kk = 0; kk < 4; ++kk) {
            const bf16x8 kf = *(const bf16x8*)(sK + row * 256 + (((kk * 4 + g) ^ li) << 4));
            sacc[st][kt] = __builtin_amdgcn_mfma_f32_16x16x32_bf16(kf, qf[kk], sacc[st][kt], 0, 0, 0);
          }
        }
      const bool diag = (tt == ntiles - 1);
      float mx = -INFINITY;
      if (diag || !__all(rowvalid)) {
#pragma unroll
        for (int st = 0; st < 2; ++st)
#pragma unroll
          for (int kt = 0; kt < 2; ++kt)
#pragma unroll
            for (int r = 0; r < 4; ++r) {
              const int key = key0 + 32 * st + 8 * g + 4 * kt + r;
              bool ok = rowvalid && (!diag || key <= qpos);
              const float sv = ok ? sacc[st][kt][r] * SC : -INFINITY;
              sacc[st][kt][r] = sv;
              mx = fmaxf(mx, sv);
            }
      } else {
#pragma unroll
        for (int st = 0; st < 2; ++st)
#pragma unroll
          for (int kt = 0; kt < 2; ++kt) {
            sacc[st][kt] *= SC;
            mx = fmaxf(mx, fmaxf(fmaxf(sacc[st][kt][0], sacc[st][kt][1]), fmaxf(sacc[st][kt][2], sacc[st][kt][3])));
          }
      }
      mx = fmaxf(mx, __shfl_xor(mx, 16));
      mx = fmaxf(mx, __shfl_xor(mx, 32));
      const float mnew = (mx > mrun + 6.f) ? mx : mrun;
      const float muse = (mnew == -INFINITY) ? 0.f : mnew;
      const bool resc = __any(mnew != mrun);
      const float alpha = __builtin_amdgcn_exp2f(mrun - muse);
      mrun = mnew;
      float ps = 0.f;
      bf16x8 pf[2];
#pragma unroll
      for (int st = 0; st < 2; ++st) {
        float pv[8];
#pragma unroll
        for (int kt = 0; kt < 2; ++kt)
#pragma unroll
          for (int r = 0; r < 4; ++r) {
            const float e = __builtin_amdgcn_exp2f(sacc[st][kt][r] - muse);
            pv[kt * 4 + r] = e;
            ps += e;
          }
        u32x4 u;
        u.x = pk_bf16(pv[0], pv[1]); u.y = pk_bf16(pv[2], pv[3]); u.z = pk_bf16(pv[4], pv[5]); u.w = pk_bf16(pv[6], pv[7]);
        pf[st] = *(bf16x8*)&u;
      }
      lrun = lrun * alpha + ps;
      if (resc) {
#pragma unroll
        for (int d = 0; d < 8; ++d) oacc[d] *= alpha;
      }
#pragma unroll
      for (int d = 0; d < 8; ++d) {
        const int row = d * 16 + li;
#pragma unroll
        for (int st = 0; st < 2; ++st) {
          const bf16x8 vf = *(const bf16x8*)(sV + row * 128 + (((st * 4 + g) ^ (li & 7)) << 4));
          oacc[d] = __builtin_amdgcn_mfma_f32_16x16x32_bf16(vf, pf[st], oacc[d], 0, 0, 0);
        }
      }
    }
    };
  for (int tt = 0; tt < ntiles; tt += 2) {
    step(tt, rkA, rvA);
    if (tt + 1 < ntiles) step(tt + 1, rkB, rvB);
  }
  lrun += __shfl_xor(lrun, 16);
  lrun += __shfl_xor(lrun, 32);
  const float inv = 1.f / lrun;
  bf16_t* ao = (bf16_t*)(ws + OFF_AO) + (size_t)(b * 4096 + qpos) * 1024 + hd * 128;
#pragma unroll
  for (int d = 0; d < 8; ++d) {
    u32x2 v;
    v.x = pk_bf16(oacc[d][0] * inv, oacc[d][1] * inv);
    v.y = pk_bf16(oacc[d][2] * inv, oacc[d][3] * inv);
    *(u32x2*)(ao + d * 16 + g * 4) = v;
  }
}

__device__ void ret_out_item(const P& p, int bh, int c) {
  char* ws = opaque(p.ws);
  const bf16_t* R = (const bf16_t*)(ws + OFF_R);
  const int b = bh >> 2, hd = bh & 3;
  const bf16_t* Q = R + R_RQ + ((size_t)bh * 4096 + c * 128) * 128;
  const bf16_t* Kp = R + R_RK + ((size_t)bh * 4096 + c * 128) * 128;
  const bf16_t* VT = R + R_RVT + (size_t)bh * 128 * 4096 + c * 128;
  const bf16_t* ST = (const bf16_t*)(ws + OFF_ST) + (size_t)(bh * 32 + c) * 16384;
  const int tid_ = otid(); const int lane = tid_ & 63, w = tid_ >> 6, li = lane & 15, g = lane >> 4;
  const float lg = LOG2G[hd];
  bf16x8 qf[2][4];
#pragma unroll
  for (int ns = 0; ns < 2; ++ns)
#pragma unroll
    for (int kk = 0; kk < 4; ++kk) qf[ns][kk] = *(const bf16x8*)(Q + (size_t)(32 * w + 16 * ns + li) * 128 + (kk * 4 + g) * 8);
  f32x4 acc[8][2];
#pragma unroll
  for (int es = 0; es < 8; ++es)
#pragma unroll
    for (int ns = 0; ns < 2; ++ns) acc[es][ns] = (f32x4){0.f, 0.f, 0.f, 0.f};
  if (c > 0) {
#pragma unroll
    for (int es = 0; es < 8; ++es)
#pragma unroll
      for (int kk = 0; kk < 4; ++kk) {
        const bf16x8 sf = *(const bf16x8*)(ST + (size_t)(es * 16 + li) * 128 + (kk * 4 + g) * 8);
#pragma unroll
        for (int ns = 0; ns < 2; ++ns) acc[es][ns] = __builtin_amdgcn_mfma_f32_16x16x32_bf16(sf, qf[ns][kk], acc[es][ns], 0, 0, 0);
      }
#pragma unroll
    for (int ns = 0; ns < 2; ++ns) {
      const float xi = exp2f((float)(32 * w + 16 * ns + li + 1) * lg);
#pragma unroll
      for (int es = 0; es < 8; ++es) {
        acc[es][ns][0] *= xi; acc[es][ns][1] *= xi; acc[es][ns][2] *= xi; acc[es][ns][3] *= xi;
      }
    }
  }
  for (int ms = 0; ms <= w; ++ms) {
    f32x4 sacc[2][2];
#pragma unroll
    for (int kt = 0; kt < 2; ++kt) {
      const int row = 32 * ms + 8 * (li >> 2) + 4 * kt + (li & 3);
#pragma unroll
      for (int ns = 0; ns < 2; ++ns) sacc[kt][ns] = (f32x4){0.f, 0.f, 0.f, 0.f};
#pragma unroll
      for (int kk = 0; kk < 4; ++kk) {
        const bf16x8 kf = *(const bf16x8*)(Kp + (size_t)row * 128 + (kk * 4 + g) * 8);
#pragma unroll
        for (int ns = 0; ns < 2; ++ns) sacc[kt][ns] = __builtin_amdgcn_mfma_f32_16x16x32_bf16(kf, qf[ns][kk], sacc[kt][ns], 0, 0, 0);
      }
    }
    bf16x8 pf[2];
#pragma unroll
    for (int ns = 0; ns < 2; ++ns) {
      const int n = 32 * w + 16 * ns + li;
      float pv[8];
#pragma unroll
      for (int kt = 0; kt < 2; ++kt)
#pragma unroll
        for (int r = 0; r < 4; ++r) {
          const int m = 32 * ms + 8 * g + 4 * kt + r;
          const float dec = (n >= m) ? exp2f((float)(n - m) * lg) : 0.f;
          pv[kt * 4 + r] = sacc[kt][ns][r] * dec;
        }
      u32x4 u;
      u.x = pk_bf16(pv[0], pv[1]); u.y = pk_bf16(pv[2], pv[3]); u.z = pk_bf16(pv[4], pv[5]); u.w = pk_bf16(pv[6], pv[7]);
      pf[ns] = *(bf16x8*)&u;
    }
#pragma unroll
    for (int es = 0; es < 8; ++es) {
      const bf16x8 vf = *(const bf16x8*)(VT + (size_t)(es * 16 + li) * 4096 + 32 * ms + 8 * g);
#pragma unroll
      for (int ns = 0; ns < 2; ++ns) acc[es][ns] = __builtin_amdgcn_mfma_f32_16x16x32_bf16(vf, pf[ns], acc[es][ns], 0, 0, 0);
    }
  }
  const bf16_t* RG = R + R_RG;
  bf16_t* ao = (bf16_t*)(ws + OFF_AO);
#pragma unroll
  for (int ns = 0; ns < 2; ++ns) {
    float ss = 0.f;
#pragma unroll
    for (int es = 0; es < 8; ++es)
#pragma unroll
      for (int r = 0; r < 4; ++r) ss += acc[es][ns][r] * acc[es][ns][r];
    ss += __shfl_xor(ss, 16);
    ss += __shfl_xor(ss, 32);
    const float rs = rsqrtf(ss * (1.f / 128.f) + 1e-6f);
    const size_t t = (size_t)b * 4096 + c * 128 + 32 * w + 16 * ns + li;
#pragma unroll
    for (int es = 0; es < 8; ++es) {
      const int e = es * 16 + g * 4;
      const u32x2 gu = *(const u32x2*)(RG + t * 512 + hd * 128 + e);
      const float gv[4] = {bf_lo(gu.x), bf_hi(gu.x), bf_lo(gu.y), bf_hi(gu.y)};
      float o[4];
#pragma unroll
      for (int r = 0; r < 4; ++r) {
        const float sg = gv[r] / (1.f + __expf(-gv[r]));
        o[r] = acc[es][ns][r] * rs * sg;
      }
      u32x2 v;
      v.x = pk_bf16(o[0], o[1]);
      v.y = pk_bf16(o[2], o[3]);
      *(u32x2*)(ao + t * 1024 + 512 + hd * 128 + e) = v;
    }
  }
}

#define CSWAP(a, b) { unsigned _h = (a) > (b) ? (a) : (b); unsigned _l = (a) > (b) ? (b) : (a); (a) = _h; (b) = _l; }

__device__ void peer_token(const P& p, int layer, int tok, bool dry, char* smem) {
  char* ws = opaque(p.ws);
  const int tid_ = otid(); const int lane = tid_ & 63, li = lane & 15, rw = lane >> 4, rbase = lane & 48;
  const bf16_t* sc = (const bf16_t*)(ws + OFF_R + R_SC_BYTES) + (size_t)tok * 2048;
  unsigned res[4];
#pragma unroll
  for (int pp = 0; pp < 4; ++pp) {
    const int head = 4 * (pp >> 1) + rw, half = pp & 1, hp = head * 2 + half;
    const u32x4 a0 = *(const u32x4*)(sc + hp * 128 + li * 8);
    unsigned k[8];
    const float vv[8] = {bf_lo(a0.x), bf_hi(a0.x), bf_lo(a0.y), bf_hi(a0.y), bf_lo(a0.z), bf_hi(a0.z), bf_lo(a0.w), bf_hi(a0.w)};
#pragma unroll
    for (int e = 0; e < 8; ++e) k[e] = (f_ord(vv[e]) & ~0x7Fu) | (unsigned)(127 - (li * 8 + e));
    CSWAP(k[0], k[1]) CSWAP(k[2], k[3]) CSWAP(k[4], k[5]) CSWAP(k[6], k[7])
    CSWAP(k[0], k[2]) CSWAP(k[1], k[3]) CSWAP(k[4], k[6]) CSWAP(k[5], k[7])
    CSWAP(k[1], k[2]) CSWAP(k[5], k[6])
    CSWAP(k[0], k[4]) CSWAP(k[1], k[5]) CSWAP(k[2], k[6]) CSWAP(k[3], k[7])
    CSWAP(k[2], k[4]) CSWAP(k[3], k[5])
    CSWAP(k[1], k[2]) CSWAP(k[3], k[4]) CSWAP(k[5], k[6])
    unsigned keep = 0;
#pragma unroll
    for (int rd = 0; rd < 16; ++rd) {
      const unsigned wk = rowmax_u(k[0]);
      if (li == rd) keep = wk;
      const bool win = (k[0] == wk);
      k[0] = win ? k[1] : k[0]; k[1] = win ? k[2] : k[1]; k[2] = win ? k[3] : k[2]; k[3] = win ? k[4] : k[3];
      k[4] = win ? k[5] : k[4]; k[5] = win ? k[6] : k[5]; k[6] = win ? k[7] : k[6]; k[7] = win ? 0u : k[7];
    }
    res[pp] = keep;
  }
  int eidx[2];
  float gate[2];
#pragma unroll
  for (int hp2 = 0; hp2 < 2; ++hp2) {
    const unsigned k1 = res[hp2 * 2], k2 = res[hp2 * 2 + 1];
    const float s1 = f_deord(k1 & ~0x7Fu), s2 = f_deord(k2 & ~0x7Fu);
    const int i1 = 127 - (int)(k1 & 0x7Fu), i2 = 127 - (int)(k2 & 0x7Fu);
    int ptr = 0;
    unsigned keep = 0;
    float s2p = __uint_as_float((unsigned)__builtin_amdgcn_ds_bpermute((rbase + 0) * 4, (int)__float_as_uint(s2)));
    unsigned hk = (f_ord(s1 + s2p) & ~0xFFu) | (unsigned)(255 - (li * 16 + 0));
#pragma unroll
    for (int rd = 0; rd < 16; ++rd) {
      const unsigned wk = rowmax_u(hk);
      if (li == rd) keep = wk;
      const bool win = (hk == wk);
      ptr += win ? 1 : 0;
      const int pcl = ptr < 15 ? ptr : 15;
      s2p = __uint_as_float((unsigned)__builtin_amdgcn_ds_bpermute((rbase + pcl) * 4, (int)__float_as_uint(s2)));
      const unsigned nk = (f_ord(s1 + s2p) & ~0xFFu) | (unsigned)(255 - (li * 16 + pcl));
      hk = win ? (ptr < 16 ? nk : 0u) : hk;
    }
    const float ts = f_deord(keep & ~0xFFu);
    const int idx8 = 255 - (int)(keep & 0xFFu);
    const int a = idx8 >> 4, bq = idx8 & 15;
    const int e1 = __builtin_amdgcn_ds_bpermute((rbase + a) * 4, i1);
    const int e2 = __builtin_amdgcn_ds_bpermute((rbase + bq) * 4, i2);
    eidx[hp2] = e1 * 128 + e2;
    const float tmax = f_deord(rowmax_u(keep) & ~0xFFu);
    const float ex = __expf(ts - tmax);
    const float sm = rowsum_f(ex);
    gate[hp2] = ex / sm;
  }
  const unsigned char* xn8 = (const unsigned char*)(ws + OFF_AO) + (32ull << 20) + (size_t)tok * 1024;
  i32x8 tq[8];
#pragma unroll
  for (int s8 = 0; s8 < 8; ++s8) {
    const u32x4 lo = *(const u32x4*)(xn8 + s8 * 128 + rw * 16);
    const u32x4 hi = *(const u32x4*)(xn8 + s8 * 128 + 64 + rw * 16);
    tq[s8] = (i32x8){(int)lo.x, (int)lo.y, (int)lo.z, (int)lo.w, (int)hi.x, (int)hi.y, (int)hi.z, (int)hi.w};
  }
  const unsigned char* U4 = (const unsigned char*)(ws + OFF_U) + (size_t)layer * 16384 * 512;
  const unsigned char* V4 = (const unsigned char*)(ws + OFF_U) + (size_t)(4 + layer) * 16384 * 512;
  const float* SU = (const float*)(ws + OFF_V) + (size_t)layer * 16384;
  const float* SV = (const float*)(ws + OFF_V) + (size_t)(4 + layer) * 16384;
  char* lw = smem + (tid_ >> 6) * 8704;
  float wreg[2];
#pragma unroll
  for (int h2 = 0; h2 < 2; ++h2) {
    const float su = SU[eidx[h2]], sv = SV[eidx[h2]];
    float hreg = 0.f;
    for (int b2 = 0; b2 < 2; ++b2) {
      u32x4 uu[16];
      const int lh = lane >> 5, l5 = lane & 31;
#pragma unroll
      for (int q = 0; q < 16; ++q) {
        const int e0 = __builtin_amdgcn_readlane(eidx[h2], b2 * 32 + 2 * q);
        const int e1 = __builtin_amdgcn_readlane(eidx[h2], b2 * 32 + 2 * q + 1);
        const int e = lh ? e1 : e0;
        uu[q] = ((const u32x4*)(U4 + (size_t)e * 512))[l5];
      }
#pragma unroll
      for (int hh = 0; hh < 2; ++hh) {
#pragma unroll
        for (int q = 0; q < 8; ++q) *(u32x4*)(lw + (2 * q + lh) * 544 + l5 * 16) = uu[hh * 8 + q];
        f32x4 acc = {0.f, 0.f, 0.f, 0.f};
#pragma unroll
        for (int s8 = 0; s8 < 8; ++s8) {
          const u32x4 a = *(const u32x4*)(lw + li * 544 + s8 * 64 + rw * 16);
          const i32x8 av = {(int)a.x, (int)a.y, (int)a.z, (int)a.w, 0, 0, 0, 0};
          acc = __builtin_amdgcn_mfma_scale_f32_16x16x128_f8f6f4(av, tq[s8], acc, 4, 0, 0, 0x7f7f7f7f, 0, 0x7f7f7f7f);
        }
        const int lr2 = li & 3;
        const float sel = lr2 == 0 ? acc[0] : lr2 == 1 ? acc[1] : lr2 == 2 ? acc[2] : acc[3];
        const float val = __uint_as_float((unsigned)__builtin_amdgcn_ds_bpermute(((li >> 2) * 16 + li) * 4, (int)__float_as_uint(sel)));
        hreg = (rw == b2 * 2 + hh) ? val : hreg;
      }
    }
    const float hid = hreg * su;
    const float ge = 0.5f * hid * (1.f + erff(hid * 0.70710678118654752f));
    wreg[h2] = gate[h2] * ge * sv;
  }
  f32x2 oa2[8];
#pragma unroll
  for (int e = 0; e < 8; ++e) oa2[e] = (f32x2){0.f, 0.f};
#pragma unroll
  for (int h2 = 0; h2 < 2; ++h2) {
    for (int jb = 0; jb < 64; jb += 32) {
      u32x2 vv[32];
#pragma unroll
      for (int q = 0; q < 32; ++q) {
        const int e = __builtin_amdgcn_readlane(eidx[h2], jb + q);
        vv[q] = ((const u32x2*)(V4 + (size_t)e * 512))[lane];
      }
#pragma unroll
      for (int q = 0; q < 32; ++q) {
        const float wq = rdlane_f(wreg[h2], jb + q);
        const f32x2 w2 = {wq, wq};
#pragma unroll
        for (int k = 0; k < 2; ++k) {
          oa2[4 * k + 0] += w2 * __builtin_amdgcn_cvt_scalef32_pk_f32_fp4(vv[q][k], 1.0f, 0);
          oa2[4 * k + 1] += w2 * __builtin_amdgcn_cvt_scalef32_pk_f32_fp4(vv[q][k], 1.0f, 1);
          oa2[4 * k + 2] += w2 * __builtin_amdgcn_cvt_scalef32_pk_f32_fp4(vv[q][k], 1.0f, 2);
          oa2[4 * k + 3] += w2 * __builtin_amdgcn_cvt_scalef32_pk_f32_fp4(vv[q][k], 1.0f, 3);
        }
      }
    }
  }
  float* hrow = (float*)(ws + OFF_H) + (size_t)tok * 1024;
  float hv[16];
#pragma unroll
  for (int k = 0; k < 4; ++k) {
    const f32x4 h4 = ((const f32x4*)hrow)[lane * 4 + k];
    hv[4 * k] = h4.x; hv[4 * k + 1] = h4.y; hv[4 * k + 2] = h4.z; hv[4 * k + 3] = h4.w;
  }
  float ss = 0.f;
#pragma unroll
  for (int e = 0; e < 8; ++e) {
    hv[2 * e] += oa2[e].x;
    hv[2 * e + 1] += oa2[e].y;
  }
#pragma unroll
  for (int e = 0; e < 16; ++e) ss += hv[e] * hv[e];
  ss = wavesum_f(ss);
  if (dry) { if (lane == 0) ((float*)(ws + OFF_S))[tok] = ss; return; }
  const float rs = rsqrtf(ss * (1.f / 1024.f) + 1e-6f);
  const float* gw = (layer < 3) ? (p.norm_mix + (size_t)(layer + 1) * 1024) : p.final_norm;
  float y[16];
#pragma unroll
  for (int k = 0; k < 4; ++k) {
    const f32x4 g4 = ((const f32x4*)gw)[lane * 4 + k];
    y[4 * k] = hv[4 * k] * rs * g4.x; y[4 * k + 1] = hv[4 * k + 1] * rs * g4.y;
    y[4 * k + 2] = hv[4 * k + 2] * rs * g4.z; y[4 * k + 3] = hv[4 * k + 3] * rs * g4.w;
  }
  if (layer < 3) {
#pragma unroll
    for (int k = 0; k < 4; ++k) ((f32x4*)hrow)[lane * 4 + k] = MAKEF4(hv[4 * k], hv[4 * k + 1], hv[4 * k + 2], hv[4 * k + 3]);
    bf16_t* xo = (bf16_t*)(ws + OFF_XN) + (size_t)tok * 1024;
    u32x4 o0, o1;
    o0.x = pk_bf16(y[0], y[1]); o0.y = pk_bf16(y[2], y[3]); o0.z = pk_bf16(y[4], y[5]); o0.w = pk_bf16(y[6], y[7]);
    o1.x = pk_bf16(y[8], y[9]); o1.y = pk_bf16(y[10], y[11]); o1.z = pk_bf16(y[12], y[13]); o1.w = pk_bf16(y[14], y[15]);
    ((u32x4*)xo)[lane * 2] = o0;
    ((u32x4*)xo)[lane * 2 + 1] = o1;
  } else {
    float* orow = p.out + (size_t)tok * 1024;
#pragma unroll
    for (int k = 0; k < 4; ++k) ((f32x4*)orow)[lane * 4 + k] = MAKEF4(y[4 * k], y[4 * k + 1], y[4 * k + 2], y[4 * k + 3]);
  }
}

__device__ void quant_rows(const float* src, unsigned char* dst, float* scales, int row_begin, int nrows) {
  const int tid_ = otid();
  const int lane = tid_ & 63, w = tid_ >> 6;
  for (int row = row_begin + blockIdx.x * 4 + w; row < nrows; row += gridDim.x * 4) {
    const f32x4* sp = (const f32x4*)(src + (size_t)row * 1024) + lane * 4;
    f32x4 v[4];
    float am = 0.f;
#pragma unroll
    for (int k = 0; k < 4; ++k) {
      v[k] = sp[k];
      am = fmaxf(am, fmaxf(fmaxf(fabsf(v[k].x), fabsf(v[k].y)), fmaxf(fabsf(v[k].z), fabsf(v[k].w))));
    }
    am = fmaxf(am, __shfl_xor(am, 1)); am = fmaxf(am, __shfl_xor(am, 2)); am = fmaxf(am, __shfl_xor(am, 4));
    am = fmaxf(am, __shfl_xor(am, 8)); am = fmaxf(am, __shfl_xor(am, 16)); am = fmaxf(am, __shfl_xor(am, 32));
    const float sc = am > 0.f ? 6.f / am : 1.f;
    u32x2 o;
#pragma unroll
    for (int k = 0; k < 2; ++k) {
      unsigned wd = 0u;
      wd = __builtin_amdgcn_cvt_scalef32_pk_fp4_f32(wd, v[2 * k].x * sc, v[2 * k].y * sc, 1.0f, 0);
      wd = __builtin_amdgcn_cvt_scalef32_pk_fp4_f32(wd, v[2 * k].z * sc, v[2 * k].w * sc, 1.0f, 1);
      wd = __builtin_amdgcn_cvt_scalef32_pk_fp4_f32(wd, v[2 * k + 1].x * sc, v[2 * k + 1].y * sc, 1.0f, 2);
      wd = __builtin_amdgcn_cvt_scalef32_pk_fp4_f32(wd, v[2 * k + 1].z * sc, v[2 * k + 1].w * sc, 1.0f, 3);
      o[k] = wd;
    }
    ((u32x2*)(dst + (size_t)row * 512))[lane] = o;
    if (lane == 0) scales[row] = am > 0.f ? am * (1.f / 6.f) : 1.f;
  }
}

__global__ void __launch_bounds__(256, 2) fwd_kernel(P p) {
  __shared__ __attribute__((aligned(16))) char smem[65536];
  cg::grid_group grid = cg::this_grid();
  char* ws = opaque(p.ws);
  XB xb;
  xb.bar = (unsigned*)(ws + OFF_BAR);
  xb.x = (unsigned)__builtin_amdgcn_s_getreg((3 << 11) | 20) & 0xFu;
  xb.nloc = 0u; xb.nx = 0u;
  if (threadIdx.x == 0) (void)xb_add(&xb.bar[XB_XCNT(xb.x)], 1u);
  const int tid = threadIdx.x;
  const int G = gridDim.x;

  if (STOP == 0) { grid.sync(); return; }
  tr_cvt_tiles(p.even_w_in, (bf16_t*)(ws + OFF_WEIN), 1024, 3584, 2, smem);
  tr_cvt_tiles(p.even_w_out, (bf16_t*)(ws + OFF_WEOUT), 1024, 1024, 2, smem);
  tr_cvt_tiles(p.odd_w_in, (bf16_t*)(ws + OFF_WOIN), 1024, 3072, 2, smem);
  tr_cvt_tiles(p.odd_w_out, (bf16_t*)(ws + OFF_WOOUT), 1024, 1024, 2, smem);
  cvt_straight(p.peer_w_q, (bf16_t*)(ws + OFF_AO), 4ull * 1024 * 2048);
  if (STOP == -1) { grid.sync(); return; }
  cvt_straight(p.peer_sub_keys, (bf16_t*)(ws + OFF_SUBK), 4ull * 8 * 2 * 128 * 128);
  quant_rows(p.peer_u, (unsigned char*)(ws + OFF_U), (float*)(ws + OFF_V), 0, 16384);
  quant_rows(p.peer_v, (unsigned char*)(ws + OFF_U) + 4ull * 16384 * 512, (float*)(ws + OFF_V) + 65536, 0, 16384);
  if (STOP == -2) { grid.sync(); return; }
  {
    float* ctab = (float*)(ws + OFF_COS);
    float* stab = (float*)(ws + OFF_SIN);
    for (int i = blockIdx.x * 256 + tid; i < 4096 * 64; i += G * 256) {
      const int s = i >> 6, d = i & 63;
      const float inv = (float)exp2(-(double)d * (13.287712379549449 / 64.0));
      const float ang = (float)s * inv;
      const double ad = (double)ang;
      const double kq = rint(ad * 0.15915494309189535);
      const float rr = (float)(ad - kq * 6.283185307179586);
      ctab[i] = __cosf(rr);
      stab[i] = __sinf(rr);
    }
  }
  if (STOP == -3) { grid.sync(); return; }
  rmsnorm_rows(p.x, p.norm_mix, (bf16_t*)(ws + OFF_XN), (float*)(ws + OFF_H));
  if (p.out == nullptr) grid.sync();
  gbar(xb);
  if (STOP == 1) return;

  for (int layer = 0; layer < 4; ++layer) {
    const int li2 = layer >> 1;
    ws = opaque(p.ws);
    const int tid = otid();
    const bf16_t* XN = (const bf16_t*)(ws + OFF_XN);
    float* H = (float*)(ws + OFF_H);
    if ((layer & 1) == 0) {
      for (int rep = 0; rep < REP_A; ++rep)
      for (int it = blockIdx.x; it < 64 * 28; it += G) even_in_tile(p, li2, (it & 7) * 8 + (it >> 3) / 28, (it >> 3) % 28, smem);
      if (layer == 0) {
        for (int it = blockIdx.x; it < 512; it += G) {
          const int lf = it >> 7, hp = (it >> 3) & 15, kc = it & 7;
          gemm_tile_fp8out<4>((const bf16_t*)(ws + OFF_SUBK) + ((size_t)lf * 16 + hp) * 16384, 128,
                              (const bf16_t*)(ws + OFF_AO) + (size_t)lf * 1024 * 2048 + (size_t)(kc * 128) * 2048 + hp * 128, 2048, 128,
                              (unsigned char*)(ws + OFF_WPQ) + ((size_t)lf * 2048 + hp * 128) * 1024 + kc * 128, 1024, 256.f, smem);
        }
      }
      gbar(xb);
      if (STOP == 2) return;
      const int qb = (layer == 0) ? 16384 : 49152, qe = (layer == 0) ? 49152 : 65536;
      if ((blockIdx.x & 256) == 0) {
        quant_rows(p.peer_u, (unsigned char*)(ws + OFF_U), (float*)(ws + OFF_V), qb, qe);
        quant_rows(p.peer_v, (unsigned char*)(ws + OFF_U) + 4ull * 16384 * 512, (float*)(ws + OFF_V) + 65536, qb, qe);
      }
      for (int rep = 0; rep < REP_B1; ++rep)
      for (int it = blockIdx.x; it < 1024 + 512; it += G) {
        if (it < 1024) {
          const int x = it >> 4, bh = it & 15;
          const int qt = (x < 32) ? (63 - x) : (x - 32);
          moba_item(p, bh, qt, smem);
        } else {
          const int idx = it - 1024, bh = idx >> 5, c = idx & 31;
          const bf16_t* Rb = (const bf16_t*)(ws + OFF_R);
          gemm_tile_f32<false, 4>(Rb + R_RVT + (size_t)bh * 128 * 4096 + c * 128, 4096,
                               Rb + R_RKT + (size_t)bh * 128 * 4096 + c * 128, 4096, 128,
                               (float*)(ws + OFF_S) + (size_t)idx * 16384, 128, smem);
        }
      }
      if ((blockIdx.x & 256) != 0) {
        quant_rows(p.peer_u, (unsigned char*)(ws + OFF_U), (float*)(ws + OFF_V), qb, qe);
        quant_rows(p.peer_v, (unsigned char*)(ws + OFF_U) + 4ull * 16384 * 512, (float*)(ws + OFF_V) + 65536, qb, qe);
      }
      gbar(xb);
      if (STOP == 3) return;
      {
        const float* S = (const float*)(ws + OFF_S);
        bf16_t* ST = (bf16_t*)(ws + OFF_ST);
        for (int i = blockIdx.x * 256 + tid; i < 16 * 16384 / 4; i += G * 256) {
          const int bh = i >> 12, off = (i & 4095) * 4;
          const float gc = exp2f(128.f * LOG2G[bh & 3]);
          f32x4 st = {0.f, 0.f, 0.f, 0.f};
          const float* Sp = S + (size_t)(bh * 32) * 16384 + off;
          bf16_t* Tp = ST + (size_t)(bh * 32) * 16384 + off;
          for (int c0 = 0; c0 < 32; c0 += 8) {
            f32x4 a[8];
#pragma unroll
            for (int c = 0; c < 8; ++c) a[c] = *(const f32x4*)(Sp + (size_t)(c0 + c) * 16384);
#pragma unroll
            for (int c = 0; c < 8; ++c) {
              u32x2 o;
              o.x = pk_bf16(st[0], st[1]); o.y = pk_bf16(st[2], st[3]);
              *(u32x2*)(Tp + (size_t)(c0 + c) * 16384) = o;
              st = st * gc + a[c];
            }
          }
        }
      }
      gbar(xb);
      if (STOP == 4) return;
      for (int rep = 0; rep < REP_B3; ++rep)
      for (int it = blockIdx.x; it < 512; it += G) ret_out_item(p, it >> 5, it & 31);
      gbar(xb);
      if (STOP == 5) return;
      for (int it = blockIdx.x; it < 64 * 8; it += G) {
        const int tm = (it & 7) * 8 + ((it >> 3) >> 3), tn = (it >> 3) & 7;
        gemm_tile_f32<true, 8>((const bf16_t*)(ws + OFF_AO) + (size_t)tm * 256 * 1024, 1024,
                            (const bf16_t*)(ws + OFF_WEOUT) + ((size_t)li2 * 1024 + tn * 128) * 1024, 1024, 1024,
                            H + (size_t)tm * 256 * 1024 + tn * 128, 1024, smem);
      }
      gbar(xb);
      if (STOP == 6) return;
    } else {
      bf16_t* PR = (bf16_t*)(ws + OFF_R);
      for (int it = blockIdx.x; it < 64 * 24; it += G) {
        const int tm = (it & 7) * 8 + (it >> 3) / 24, tn = (it >> 3) % 24;
        gemm_tile_bf16<8>(XN + (size_t)tm * 256 * 1024, 1024,
                       (const bf16_t*)(ws + OFF_WOIN) + ((size_t)li2 * 3072 + tn * 128) * 1024, 1024, 1024,
                       PR + (size_t)tm * 256 * 3072 + tn * 128, 3072, smem);
      }
      gbar(xb);
      if (STOP == 11) return;
      {
        bf16_t* AO = (bf16_t*)(ws + OFF_AO);
        const float* cw = p.odd_conv + (size_t)li2 * 3 * 1024;
        for (int i = blockIdx.x * 256 + tid; i < T_TOK * 128; i += G * 256) {
          const int t = i >> 7, c8 = (i & 127) * 8;
          const int s = t & 4095;
          const bf16_t* row = PR + (size_t)t * 3072;
          const u32x4 bg = *(const u32x4*)(row + c8);
          float u[3][8];
#pragma unroll
          for (int dt = 0; dt < 3; ++dt) {
            if (s - dt >= 0) {
              const u32x4 cg4 = *(const u32x4*)(row - (size_t)dt * 3072 + 1024 + c8);
              const u32x4 hx4 = *(const u32x4*)(row - (size_t)dt * 3072 + 2048 + c8);
              u[dt][0] = bf_lo(cg4.x) * bf_lo(hx4.x); u[dt][1] = bf_hi(cg4.x) * bf_hi(hx4.x);
              u[dt][2] = bf_lo(cg4.y) * bf_lo(hx4.y); u[dt][3] = bf_hi(cg4.y) * bf_hi(hx4.y);
              u[dt][4] = bf_lo(cg4.z) * bf_lo(hx4.z); u[dt][5] = bf_hi(cg4.z) * bf_hi(hx4.z);
              u[dt][6] = bf_lo(cg4.w) * bf_lo(hx4.w); u[dt][7] = bf_hi(cg4.w) * bf_hi(hx4.w);
            } else {
#pragma unroll
              for (int e = 0; e < 8; ++e) u[dt][e] = 0.f;
            }
          }
          const float bgf[8] = {bf_lo(bg.x), bf_hi(bg.x), bf_lo(bg.y), bf_hi(bg.y), bf_lo(bg.z), bf_hi(bg.z), bf_lo(bg.w), bf_hi(bg.w)};
          float y[8];
#pragma unroll
          for (int e = 0; e < 8; ++e) {
            const float w0 = cw[c8 + e], w1 = cw[1024 + c8 + e], w2 = cw[2048 + c8 + e];
            y[e] = bgf[e] * (w0 * u[2][e] + w1 * u[1][e] + w2 * u[0][e]);
          }
          u32x4 o;
          o.x = pk_bf16(y[0], y[1]); o.y = pk_bf16(y[2], y[3]); o.z = pk_bf16(y[4], y[5]); o.w = pk_bf16(y[6], y[7]);
          *(u32x4*)(AO + (size_t)t * 1024 + c8) = o;
        }
      }
      gbar(xb);
      if (STOP == 12) return;
      for (int it = blockIdx.x; it < 64 * 8; it += G) {
        const int tm = (it & 7) * 8 + ((it >> 3) >> 3), tn = (it >> 3) & 7;
        gemm_tile_f32<true, 8>((const bf16_t*)(ws + OFF_AO) + (size_t)tm * 256 * 1024, 1024,
                            (const bf16_t*)(ws + OFF_WOOUT) + ((size_t)li2 * 1024 + tn * 128) * 1024, 1024, 1024,
                            H + (size_t)tm * 256 * 1024 + tn * 128, 1024, smem);
      }
      gbar(xb);
      if (STOP == 13) return;
    }
    rmsnorm_rows(H, p.norm_ffn + (size_t)layer * 1024, nullptr, nullptr, (unsigned char*)(ws + OFF_AO) + (32ull << 20));
    gbar(xb);
      if (STOP == 7) return;
    {
      bf16_t* SCB = (bf16_t*)(ws + OFF_R + R_SC_BYTES);
      for (int rep = 0; rep < REP_E; ++rep)
      for (int it = blockIdx.x; it < 64 * 16; it += G) {
        const int tm = (it & 7) * 8 + ((it >> 3) >> 4), tn = (it >> 3) & 15;
        gemm_tile_bf16<8, true>((const bf16_t*)(ws + OFF_AO + (32ull << 20)) + (size_t)tm * 256 * 512, 512,
                       (const bf16_t*)(ws + OFF_WPQ) + ((size_t)layer * 2048 + tn * 128) * 512, 512, 512,
                       SCB + (size_t)tm * 256 * 2048 + tn * 128, 2048, smem);
      }
      gbar(xb);
      if (STOP == 8) return;
    }
    for (int rep = 0; rep < REP_F; ++rep)
    for (int it = blockIdx.x; it < T_TOK / 4; it += G) peer_token(p, layer, it * 4 + (otid() >> 6), rep + 1 < REP_F, smem);
    gbar(xb);
      if (STOP == 10) return;
  }
}

extern "C" void kernel_launch(void* const* d_in, const int* in_sizes, int n_in, void* d_out, int out_size, void* d_ws,
                              size_t ws_size, hipStream_t stream) {
  static int grid_blocks = 0;
  if (!grid_blocks) {
    int dev = 0, cus = 0, per_cu = 0;
    hipGetDevice(&dev);
    hipDeviceGetAttribute(&cus, hipDeviceAttributeMultiprocessorCount, dev);
    hipOccupancyMaxActiveBlocksPerMultiprocessor(&per_cu, fwd_kernel, 256, 0);
    if (per_cu > 2) per_cu = 2;
    grid_blocks = cus * per_cu;
  }
  if (ws_size < WS_NEED) {
    fprintf(stderr, "workspace too small: %zu < %zu\n", ws_size, (size_t)WS_NEED);
    return;
  }
  P p{};
  p.x = (const float*)d_in[0];
  p.norm_mix = (const float*)d_in[1];
  p.norm_ffn = (const float*)d_in[2];
  p.even_w_in = (const float*)d_in[3];
  p.even_w_out = (const float*)d_in[4];
  p.odd_w_in = (const float*)d_in[5];
  p.odd_conv = (const float*)d_in[6];
  p.odd_w_out = (const float*)d_in[7];
  p.peer_w_q = (const float*)d_in[8];
  p.peer_sub_keys = (const float*)d_in[9];
  p.peer_u = (const float*)d_in[10];
  p.peer_v = (const float*)d_in[11];
  p.final_norm = (const float*)d_in[12];
  p.out = (float*)d_out;
  p.ws = (char*)d_ws;
  (void)hipMemsetAsync(d_ws, 0, 16384, stream);
  void* args[] = {&p};
  hipError_t e = hipLaunchCooperativeKernel((void*)fwd_kernel, dim3(grid_blocks), dim3(256), args, 0, stream);
  if (e != hipSuccess) {
    fprintf(stderr, "cooperative launch failed: %s (grid %d)\n", hipGetErrorString(e), grid_blocks);
    (void)hipGetLastError();
    grid_blocks = 256;
    e = hipLaunchCooperativeKernel((void*)fwd_kernel, dim3(grid_blocks), dim3(256), args, 0, stream);
    if (e != hipSuccess) fprintf(stderr, "cooperative launch failed again: %s\n", hipGetErrorString(e));
  }
}
```

```cpp
#include <hip/hip_runtime.h>
#include <hip/hip_cooperative_groups.h>
#include <cstdio>
namespace cg = cooperative_groups;

typedef unsigned short bf16_t;
typedef short bf16x8 __attribute__((ext_vector_type(8)));
typedef float f32x4 __attribute__((ext_vector_type(4)));
typedef unsigned u32x4 __attribute__((ext_vector_type(4)));
typedef unsigned u32x2 __attribute__((ext_vector_type(2)));
typedef float f32x2 __attribute__((ext_vector_type(2)));
typedef int i32x8 __attribute__((ext_vector_type(8)));
__device__ __forceinline__ f32x4 MAKEF4(float a, float b, float c, float d) { f32x4 r = {a, b, c, d}; return r; }

#ifndef STOP
#define STOP 99
#endif
#ifndef REP_E
#define REP_E 1
#endif
#ifndef REP_B1
#define REP_B1 1
#endif
#ifndef REP_A
#define REP_A 1
#endif
#ifndef REP_B3
#define REP_B3 1
#endif
#ifndef REP_F
#define REP_F 1
#endif
#define T_TOK 16384
#define DM 1024
#define SEQL 4096

constexpr size_t OFF_BAR   = 0;
constexpr size_t OFF_COS   = 16384;
constexpr size_t OFF_SIN   = OFF_COS + 4096ull * 64 * 4;
constexpr size_t OFF_KPART = OFF_SIN + 4096ull * 64 * 4;
constexpr size_t OFF_WEIN  = OFF_KPART + 256ull * 4 * 128 * 4;
constexpr size_t OFF_WEOUT = OFF_WEIN + 2ull * 3584 * 1024 * 2;
constexpr size_t OFF_WOIN  = OFF_WEOUT + 2ull * 1024 * 2048 * 2;
constexpr size_t OFF_WOOUT = OFF_WOIN + 2ull * 3072 * 1024 * 2;
constexpr size_t OFF_WPQ   = OFF_WOOUT + 2ull * 1024 * 1024 * 2;
constexpr size_t OFF_SUBK  = OFF_WPQ + 4ull * 2048 * 1024 * 2;
constexpr size_t OFF_U     = OFF_SUBK + 4ull * 8 * 2 * 128 * 128 * 2;
constexpr size_t OFF_V     = OFF_U + 4ull * 16384 * 1024 * 2;
constexpr size_t OFF_H     = OFF_V + 4ull * 16384 * 1024 * 2;
constexpr size_t OFF_XN    = OFF_H + 16384ull * 1024 * 4;
constexpr size_t OFF_R     = OFF_XN + 16384ull * 1024 * 2;
constexpr size_t R_BYTES   = 192ull << 20;
constexpr size_t OFF_AO    = OFF_R + R_BYTES;
constexpr size_t OFF_S     = OFF_AO + 16384ull * 2048 * 2;
constexpr size_t OFF_ST    = OFF_S + 16ull * 32 * 128 * 128 * 4;
constexpr size_t WS_NEED   = OFF_ST + 16ull * 32 * 128 * 128 * 2;
constexpr size_t HEADBUF = 16ull * 4096 * 128;
constexpr size_t R_MQ = 0, R_MK = HEADBUF, R_MVT = 2 * HEADBUF, R_RQ = 3 * HEADBUF, R_RK = 4 * HEADBUF,
                 R_RKT = 5 * HEADBUF, R_RVT = 6 * HEADBUF, R_RG = 7 * HEADBUF;
constexpr size_t R_SC_BYTES = 64ull << 20;

struct P {
  const float *x, *norm_mix, *norm_ffn, *even_w_in, *even_w_out, *odd_w_in, *odd_conv, *odd_w_out,
      *peer_w_q, *peer_sub_keys, *peer_u, *peer_v, *final_norm;
  float* out;
  char* ws;
};

__device__ __forceinline__ int otid() { int t = threadIdx.x; asm volatile("" : "+v"(t)); return t; }
typedef __attribute__((address_space(1))) char gchar_t;
__device__ __forceinline__ char* opaque(char* q) { size_t z = 0; asm volatile("" : "+s"(z)); return q + z; }
typedef __bf16 bf16x2_t __attribute__((ext_vector_type(2)));
__device__ __forceinline__ unsigned pk_bf16(float lo, float hi) {
  bf16x2_t v = {(__bf16)lo, (__bf16)hi};
  return __builtin_bit_cast(unsigned, v);
}
__device__ __forceinline__ bf16_t f2bf(float f) { return (bf16_t)(pk_bf16(f, 0.f) & 0xffffu); }
__device__ __forceinline__ float bf_lo(unsigned u) { return __uint_as_float(u << 16); }
__device__ __forceinline__ float bf_hi(unsigned u) { return __uint_as_float(u & 0xffff0000u); }
__device__ __forceinline__ float bf2f(bf16_t h) { return __uint_as_float(((unsigned)h) << 16); }

template <int CTRL>
__device__ __forceinline__ unsigned dpp_u(unsigned x) {
  return (unsigned)__builtin_amdgcn_update_dpp(0, (int)x, CTRL, 0xF, 0xF, false);
}
__device__ __forceinline__ unsigned rowmax_u(unsigned x) {
  unsigned y;
  y = dpp_u<0x121>(x); x = x > y ? x : y;
  y = dpp_u<0x122>(x); x = x > y ? x : y;
  y = dpp_u<0x124>(x); x = x > y ? x : y;
  y = dpp_u<0x128>(x); x = x > y ? x : y;
  return x;
}
__device__ __forceinline__ float rowsum_f(float x) {
  x += __uint_as_float(dpp_u<0x121>(__float_as_uint(x)));
  x += __uint_as_float(dpp_u<0x122>(__float_as_uint(x)));
  x += __uint_as_float(dpp_u<0x124>(__float_as_uint(x)));
  x += __uint_as_float(dpp_u<0x128>(__float_as_uint(x)));
  return x;
}
__device__ __forceinline__ float rdlane_f(float x, int l) {
  return __uint_as_float((unsigned)__builtin_amdgcn_readlane((int)__float_as_uint(x), l));
}
__device__ __forceinline__ float wavesum_f(float x) {
  x = rowsum_f(x);
  return rdlane_f(x, 0) + rdlane_f(x, 16) + rdlane_f(x, 32) + rdlane_f(x, 48);
}
__device__ __forceinline__ unsigned f_ord(float v) {
  unsigned u = __float_as_uint(v);
  return (u & 0x80000000u) ? ~u : (u | 0x80000000u);
}
__device__ __forceinline__ float f_deord(unsigned u) {
  return __uint_as_float((u & 0x80000000u) ? (u ^ 0x80000000u) : ~u);
}

#define XB_TMO 128
#define XB_XCNT(j) (256 + 64 * (j))
#define XB_XSUB(j) (1280 + 64 * (j))
#define XB_XGEN(j) (2304 + 64 * (j))
#define XB_TOP 3328
#define XB_TOPGEN 3392
#define XB_SPIN_CAP (1u << 22)
__device__ __forceinline__ unsigned xb_ld(unsigned* q) { return __hip_atomic_load(q, __ATOMIC_RELAXED, __HIP_MEMORY_SCOPE_AGENT); }
__device__ __forceinline__ unsigned xb_add(unsigned* q, unsigned v) { return __hip_atomic_fetch_add(q, v, __ATOMIC_RELAXED, __HIP_MEMORY_SCOPE_AGENT); }
#define XB_SPIN(cond, bar) do { unsigned _sp = 0; while (cond) { __builtin_amdgcn_s_sleep(1); \
    if ((++_sp & 255u) == 0u) { if (xb_ld(&(bar)[XB_TMO])) break; if (_sp > XB_SPIN_CAP) { atomicAdd(&(bar)[XB_TMO], 1u); break; } } } } while (0)
__device__ __forceinline__ void xb_complete(unsigned* bar, unsigned x, unsigned& nloc, unsigned& nx) {
  const unsigned G = gridDim.x;
  unsigned sum, cnt, mine, sp = 0u;
  for (;;) {
    sum = 0u; cnt = 0u; mine = 0u;
#pragma unroll
    for (unsigned j = 0; j < 16; ++j) { const unsigned c = xb_ld(&bar[XB_XCNT(j)]); sum += c; cnt += (c > 0u) ? 1u : 0u; mine = (j == x) ? c : mine; }
    if (sum == G) break;
    __builtin_amdgcn_s_sleep(1);
    if ((++sp & 255u) == 0u) { if (xb_ld(&bar[XB_TMO])) break; if (sp > XB_SPIN_CAP) { atomicAdd(&bar[XB_TMO], 1u); break; } }
  }
  nloc = mine > 0u ? mine : 1u; nx = cnt > 0u ? cnt : 1u;
}
__device__ __forceinline__ void gbar(unsigned* bar, volatile unsigned* st) {
  asm volatile("s_waitcnt vmcnt(0) lgkmcnt(0)" ::: "memory");
  __syncthreads();
  if (threadIdx.x == 0) {
    const unsigned x = (unsigned)__builtin_amdgcn_s_getreg((3 << 11) | 20) & 0xFu;
    unsigned nloc = st[0], nx = st[1];
    if (nloc == 0u) { xb_complete(bar, x, nloc, nx); st[0] = nloc; st[1] = nx; }
    const unsigned old = xb_add(&bar[XB_XSUB(x)], 1u);
    const unsigned gen = old / nloc;
    if (old + 1u == (gen + 1u) * nloc) {
      __builtin_amdgcn_fence(__ATOMIC_RELEASE, "agent");
      asm volatile("s_waitcnt vmcnt(0)" ::: "memory");
      const unsigned og = xb_add(&bar[XB_TOP], 1u);
      const unsigned tg = og / nx;
      if (og + 1u == (tg + 1u) * nx) xb_add(&bar[XB_TOPGEN], 1u);
      else XB_SPIN(xb_ld(&bar[XB_TOPGEN]) == tg, bar);
      __builtin_amdgcn_fence(__ATOMIC_ACQUIRE, "agent");
      xb_add(&bar[XB_XGEN(x)], 1u);
      asm volatile("s_waitcnt vmcnt(0)" ::: "memory");
    } else {
      XB_SPIN(xb_ld(&bar[XB_XGEN(x)]) == gen, bar);
      __builtin_amdgcn_fence(__ATOMIC_ACQUIRE, "agent");
      asm volatile("s_waitcnt vmcnt(0)" ::: "memory");
    }
  }
  __syncthreads();
}

template <int MI, bool SWAP, bool F8 = false>
__device__ __forceinline__ void gemm_core(const bf16_t* __restrict__ A, int lda, const bf16_t* __restrict__ B, int ldb,
                                          int K, char* smem, f32x4 (&acc)[MI][4]) {
  const int tid = otid(), lane = tid & 63, w = tid >> 6, wm = w >> 1, wn = w & 1;
  const int lr = tid >> 3, lc = tid & 7;
  const int li = lane & 15, g = lane >> 4;
  u32x4 ra[MI], rb[4];
  const bf16_t* ap = A + (size_t)lr * lda + lc * 8;
  const bf16_t* bp = B + (size_t)lr * ldb + lc * 8;
#pragma unroll
  for (int i = 0; i < MI; ++i)
#pragma unroll
    for (int j = 0; j < 4; ++j) acc[i][j] = (f32x4){0.f, 0.f, 0.f, 0.f};
  const int nk = K >> 6;
#pragma unroll
  for (int i = 0; i < MI; ++i) ra[i] = *(const u32x4*)(ap + (size_t)(32 * i) * lda);
#pragma unroll
  for (int i = 0; i < 4; ++i) rb[i] = *(const u32x4*)(bp + (size_t)(32 * i) * ldb);
  const int woff = lr * 128 + ((lc ^ (lr & 7)) << 4);
  const int xrow = (wm * 16 * MI + li) * 128;
  const int wrow = 32768 + (wn * 32 + li) * 128;
  for (int kt = 0; kt < nk; ++kt) {
    __syncthreads();
#pragma unroll
    for (int i = 0; i < MI; ++i) *(u32x4*)(smem + woff + i * 4096) = ra[i];
#pragma unroll
    for (int i = 0; i < 4; ++i) *(u32x4*)(smem + 32768 + woff + i * 4096) = rb[i];
    __syncthreads();
    if (kt + 1 < nk) {
#pragma unroll
      for (int i = 0; i < MI; ++i) ra[i] = *(const u32x4*)(ap + (size_t)(32 * i) * lda + (kt + 1) * 64);
#pragma unroll
      for (int i = 0; i < 4; ++i) rb[i] = *(const u32x4*)(bp + (size_t)(32 * i) * ldb + (kt + 1) * 64);
    }
    if (F8) {
      const int c0 = (g ^ (li & 7)) << 4, c1 = ((4 + g) ^ (li & 7)) << 4;
      i32x8 wf8[4];
#pragma unroll
      for (int j = 0; j < 4; ++j) {
        const char* rp = smem + wrow + ((j & 1) * 16 + (j >> 1) * 64) * 128;
        const u32x4 lo = *(const u32x4*)(rp + c0), hi = *(const u32x4*)(rp + c1);
        wf8[j] = (i32x8){(int)lo.x, (int)lo.y, (int)lo.z, (int)lo.w, (int)hi.x, (int)hi.y, (int)hi.z, (int)hi.w};
      }
#pragma unroll
      for (int i = 0; i < MI; ++i) {
        const char* rp = smem + xrow + i * 2048;
        const u32x4 lo = *(const u32x4*)(rp + c0), hi = *(const u32x4*)(rp + c1);
        const i32x8 xf8 = {(int)lo.x, (int)lo.y, (int)lo.z, (int)lo.w, (int)hi.x, (int)hi.y, (int)hi.z, (int)hi.w};
#pragma unroll
        for (int j = 0; j < 4; ++j)
          acc[i][j] = __builtin_amdgcn_mfma_scale_f32_16x16x128_f8f6f4(wf8[j], xf8, acc[i][j], 0, 0, 0, 0x77777777, 0, 0x7f7f7f7f);
      }
    } else {
#pragma unroll
    for (int kk = 0; kk < 2; ++kk) {
      const int ch = ((kk * 4 + g) ^ (li & 7)) << 4;
      bf16x8 xf[MI], wf[4];
#pragma unroll
      for (int j = 0; j < 4; ++j) wf[j] = *(const bf16x8*)(smem + wrow + ((j & 1) * 16 + (j >> 1) * 64) * 128 + ch);
#pragma unroll
      for (int i = 0; i < MI; ++i) xf[i] = *(const bf16x8*)(smem + xrow + i * 2048 + ch);
#pragma unroll
      for (int i = 0; i < MI; ++i)
#pragma unroll
        for (int j = 0; j < 4; ++j) {
          if (SWAP) acc[i][j] = __builtin_amdgcn_mfma_f32_16x16x32_bf16(xf[i], wf[j], acc[i][j], 0, 0, 0);
          else acc[i][j] = __builtin_amdgcn_mfma_f32_16x16x32_bf16(wf[j], xf[i], acc[i][j], 0, 0, 0);
        }
    }
    }
  }
}

#define EPI_COORDS                                                             \
  const int tid_ = otid(); const int lane = tid_ & 63, w = tid_ >> 6, wm = w >> 1, wn = w & 1; \
  const int li = lane & 15, g = lane >> 4;                                     \
  (void)wm; (void)wn; (void)li; (void)g;
#define NCOL(j) (((j) & 1) * 16 + wn * 32 + ((j) >> 1) * 64 + g * 4)
#define MROW(i) (wm * 16 * MI + (i) * 16 + li)
#define NCOLS(j) (((j) & 1) * 16 + wn * 32 + ((j) >> 1) * 64 + li)
#define MROWS(i) (wm * 16 * MI + (i) * 16 + g * 4)

template <int MI, bool F8 = false>
__device__ void gemm_tile_bf16(const bf16_t* A, int lda, const bf16_t* B, int ldb, int K, bf16_t* C, int ldc, char* smem) {
  f32x4 acc[MI][4];
  gemm_core<MI, false, F8>(A, lda, B, ldb, K, smem, acc);
  EPI_COORDS
#pragma unroll
  for (int i = 0; i < MI; ++i)
#pragma unroll
    for (int j = 0; j < 4; ++j) {
      u32x2 v;
      v.x = pk_bf16(acc[i][j][0], acc[i][j][1]);
      v.y = pk_bf16(acc[i][j][2], acc[i][j][3]);
      *(u32x2*)(C + (size_t)MROW(i) * ldc + NCOL(j)) = v;
    }
}
template <int MI>
__device__ void gemm_tile_fp8out(const bf16_t* A, int lda, const bf16_t* B, int ldb, int K, unsigned char* C, int ldc, float mul, char* smem) {
  f32x4 acc[MI][4];
  gemm_core<MI, false>(A, lda, B, ldb, K, smem, acc);
  EPI_COORDS
#pragma unroll
  for (int i = 0; i < MI; ++i)
#pragma unroll
    for (int j = 0; j < 4; ++j) {
      int wd = __builtin_amdgcn_cvt_pk_fp8_f32(acc[i][j][0] * mul, acc[i][j][1] * mul, 0, false);
      wd = __builtin_amdgcn_cvt_pk_fp8_f32(acc[i][j][2] * mul, acc[i][j][3] * mul, wd, true);
      *(int*)(C + (size_t)MROW(i) * ldc + NCOL(j)) = wd;
    }
}
template <bool ACCUM, int MI>
__device__ void gemm_tile_f32(const bf16_t* A, int lda, const bf16_t* B, int ldb, int K, float* C, int ldc, char* smem) {
  f32x4 acc[MI][4];
  gemm_core<MI, false>(A, lda, B, ldb, K, smem, acc);
  EPI_COORDS
#pragma unroll
  for (int i = 0; i < MI; ++i)
#pragma unroll
    for (int j = 0; j < 4; ++j) {
      f32x4* cp = (f32x4*)(C + (size_t)MROW(i) * ldc + NCOL(j));
      f32x4 v = acc[i][j];
      if (ACCUM) v += *cp;
      *cp = v;
    }
}

__device__ __constant__ float LOG2G[4] = {-0.04580368961312479f, -0.02272007650008353f, -0.011315313227834146f,
                                          -0.005646563141142063f};

__device__ void even_in_tile(const P& p, int li_even, int tm, int tn, char* smem) {
  constexpr int MI = 8;
  char* ws = opaque(p.ws);
  const bf16_t* A = (const bf16_t*)(ws + OFF_XN) + (size_t)tm * 256 * 1024;
  const bf16_t* B = (const bf16_t*)(ws + OFF_WEIN) + ((size_t)li_even * 3584 + (size_t)tn * 128) * 1024;
  const int seg = tn >> 2, hd = tn & 3;
  const int t0 = tm * 256, b = t0 >> 12, s0 = t0 & 4095, bh = b * 4 + hd;
  bf16_t* R = (bf16_t*)(ws + OFF_R);
  f32x4 acc[MI][4];
  if (seg == 2 || seg == 5) {
    gemm_core<MI, true>(A, 1024, B, 1024, 1024, smem, acc);
    EPI_COORDS
    bf16_t* dst = R + (seg == 2 ? R_MVT : R_RVT) + (size_t)bh * 128 * 4096;
#pragma unroll
    for (int i = 0; i < MI; ++i)
#pragma unroll
      for (int j = 0; j < 4; ++j) {
        u32x2 v;
        v.x = pk_bf16(acc[i][j][0], acc[i][j][1]);
        v.y = pk_bf16(acc[i][j][2], acc[i][j][3]);
        *(u32x2*)(dst + (size_t)NCOLS(j) * 4096 + s0 + MROWS(i)) = v;
      }
    return;
  }
  gemm_core<MI, false>(A, 1024, B, 1024, 1024, smem, acc);
  EPI_COORDS
  if (seg != 6) {
    const float* ctab = (const float*)(ws + OFF_COS);
    const float* stab = (const float*)(ws + OFF_SIN);
#pragma unroll
    for (int i = 0; i < MI; ++i) {
      const int s = s0 + MROW(i);
#pragma unroll
      for (int jj = 0; jj < 2; ++jj) {
        const int d = wn * 32 + jj * 16 + g * 4;
        const f32x4 c = *(const f32x4*)(ctab + s * 64 + d);
        const f32x4 sn = *(const f32x4*)(stab + s * 64 + d);
#pragma unroll
        for (int r = 0; r < 4; ++r) {
          const float a = acc[i][jj][r], bb = acc[i][jj + 2][r];
          acc[i][jj][r] = a * c[r] - bb * sn[r];
          acc[i][jj + 2][r] = bb * c[r] + a * sn[r];
        }
      }
    }
  }
  if (seg == 1) {
#pragma unroll
    for (int ih = 0; ih < 2; ++ih) {
      float* kp = (float*)(ws + OFF_KPART) + ((size_t)(tm * 4 + wm * 2 + ih) * 4 + hd) * 128;
#pragma unroll
      for (int j = 0; j < 4; ++j)
#pragma unroll
        for (int r = 0; r < 4; ++r) {
          float sm = acc[ih * 4][j][r] + acc[ih * 4 + 1][j][r] + acc[ih * 4 + 2][j][r] + acc[ih * 4 + 3][j][r];
          sm = rowsum_f(sm);
          if (li == 0) kp[NCOL(j) + r] = sm;
        }
    }
  }
  if (seg == 4) {
#pragma unroll
    for (int i = 0; i < MI; ++i)
#pragma unroll
      for (int j = 0; j < 4; ++j) acc[i][j] *= 0.08838834764831843f;
  }
  if (seg != 6) {
    bf16_t* dst = R + (seg == 0 ? R_MQ : seg == 1 ? R_MK : seg == 3 ? R_RQ : R_RK) + (size_t)bh * 4096 * 128;
#pragma unroll
    for (int i = 0; i < MI; ++i)
#pragma unroll
      for (int j = 0; j < 4; ++j) {
        u32x2 v;
        v.x = pk_bf16(acc[i][j][0], acc[i][j][1]);
        v.y = pk_bf16(acc[i][j][2], acc[i][j][3]);
        *(u32x2*)(dst + (size_t)(s0 + MROW(i)) * 128 + NCOL(j)) = v;
      }
  }
  if (seg == 4) {
    bf16_t* dst = R + R_RKT + (size_t)bh * 128 * 4096;
    const float lg = LOG2G[hd];
#pragma unroll
    for (int i = 0; i < MI; ++i) {
      const int s = s0 + MROW(i);
      const float z = exp2f((float)(127 - (s & 127)) * lg);
#pragma unroll
      for (int j = 0; j < 4; ++j)
#pragma unroll
        for (int r = 0; r < 4; ++r) dst[(size_t)(NCOL(j) + r) * 4096 + s] = f2bf(acc[i][j][r] * z);
    }
  }
  if (seg == 6) {
    bf16_t* dst = R + R_RG;
#pragma unroll
    for (int i = 0; i < MI; ++i)
#pragma unroll
      for (int j = 0; j < 4; ++j) {
        u32x2 v;
        v.x = pk_bf16(acc[i][j][0], acc[i][j][1]);
        v.y = pk_bf16(acc[i][j][2], acc[i][j][3]);
        *(u32x2*)(dst + (size_t)(t0 + MROW(i)) * 512 + hd * 128 + NCOL(j)) = v;
      }
  }
}

__device__ void tr_cvt_tiles(const float* src, bf16_t* dst, int K, int N, int nl, char* smem) {
  float(*t)[65] = (float(*)[65])smem;
  const int tk = K >> 6, tnn = N >> 6, per = tk * tnn, total = per * nl;
  const int tid = threadIdx.x;
  for (int it = blockIdx.x; it < total; it += gridDim.x) {
    const int l = it / per, rem = it % per, kt = rem / tnn, nt = rem % tnn;
    const float* s = src + (size_t)l * K * N + (size_t)kt * 64 * N + nt * 64;
    bf16_t* d = dst + (size_t)l * K * N + (size_t)nt * 64 * K + kt * 64;
    __syncthreads();
#pragma unroll
    for (int i = 0; i < 16; ++i) {
      const int e = tid + i * 256, r = e >> 6, c = e & 63;
      t[r][c] = s[(size_t)r * N + c];
    }
    __syncthreads();
#pragma unroll
    for (int i = 0; i < 16; ++i) {
      const int e = tid + i * 256, n = e >> 6, k = e & 63;
      d[(size_t)n * K + k] = f2bf(t[k][n]);
    }
  }
}
__device__ void cvt_straight(const float* src, bf16_t* dst, size_t n) {
  const size_t n4 = n >> 2;
  for (size_t i = (size_t)blockIdx.x * 256 + threadIdx.x; i < n4; i += (size_t)gridDim.x * 256) {
    const f32x4 v = ((const f32x4*)src)[i];
    u32x2 o;
    o.x = pk_bf16(v.x, v.y);
    o.y = pk_bf16(v.z, v.w);
    ((u32x2*)dst)[i] = o;
  }
}
__device__ void rmsnorm_rows(const float* src, const float* gw, bf16_t* dst, float* copy, unsigned char* dst8 = nullptr) {
  const int tid_ = otid(); const int lane = tid_ & 63, w = tid_ >> 6;
  f32x4 gg[4];
#pragma unroll
  for (int k = 0; k < 4; ++k) gg[k] = ((const f32x4*)gw)[lane + 64 * k];
  const int stride = gridDim.x * 4;
  for (int row0 = blockIdx.x * 4 + w; row0 < T_TOK; row0 += stride * 4) {
    f32x4 v[4][4];
#pragma unroll
    for (int rr = 0; rr < 4; ++rr) {
      const int row = row0 + rr * stride;
      if (row < T_TOK) {
        const f32x4* sp = (const f32x4*)(src + (size_t)row * 1024);
#pragma unroll
        for (int k = 0; k < 4; ++k) v[rr][k] = sp[lane + 64 * k];
      }
    }
#pragma unroll
    for (int rr = 0; rr < 4; ++rr) {
      const int row = row0 + rr * stride;
      if (row < T_TOK) {
        float ss = 0.f;
#pragma unroll
        for (int k = 0; k < 4; ++k) ss += v[rr][k].x * v[rr][k].x + v[rr][k].y * v[rr][k].y + v[rr][k].z * v[rr][k].z + v[rr][k].w * v[rr][k].w;
        ss = wavesum_f(ss);
        const float rs = rsqrtf(ss * (1.f / 1024.f) + 1e-6f);
#pragma unroll
        for (int k = 0; k < 4; ++k) {
          const f32x4 y = v[rr][k] * rs * gg[k];
          u32x2 o;
          o.x = pk_bf16(y.x, y.y);
          o.y = pk_bf16(y.z, y.w);
          if (dst) ((u32x2*)(dst + (size_t)row * 1024))[lane + 64 * k] = o;
          if (dst8) {
            int wd = __builtin_amdgcn_cvt_pk_fp8_f32(y.x, y.y, 0, false);
            wd = __builtin_amdgcn_cvt_pk_fp8_f32(y.z, y.w, wd, true);
            ((int*)(dst8 + (size_t)row * 1024))[lane + 64 * k] = wd;
          }
          if (copy) ((f32x4*)(copy + (size_t)row * 1024))[lane + 64 * k] = v[rr][k];
        }
      }
    }
  }
}

__device__ void moba_item(const P& p, int bh, int qt, char* smem) {
  char* ws = opaque(p.ws);
  const bf16_t* R = (const bf16_t*)(ws + OFF_R);
  const bf16_t* Q = R + R_MQ + (size_t)bh * 4096 * 128;
  const bf16_t* Kp = R + R_MK + (size_t)bh * 4096 * 128;
  const bf16_t* VT = R + R_MVT + (size_t)bh * 128 * 4096;
  const int b = bh >> 2, hd = bh & 3;
  const int qblk = qt >> 2, qin = qt & 3;
  const int q0 = qt * 64;
  const int tid = otid(), lane = tid & 63, w = tid >> 6, li = lane & 15, g = lane >> 4;
  char* sK = smem;
  char* sV = smem + 16384;
  float* sGate = (float*)(smem + 32768);
  unsigned* sMask = (unsigned*)(smem + 36864);
  float* sKm = (float*)(smem + 37120);
  __syncthreads();
  {
    const float* kp = (const float*)(ws + OFF_KPART);
    for (int e = tid; e < qblk * 128; e += 256) {
      const int n = e >> 7, d = e & 127;
      float sm = 0.f;
#pragma unroll
      for (int x4 = 0; x4 < 4; ++x4) sm += kp[((size_t)(b * 64 + n * 4 + x4) * 4 + hd) * 128 + d];
      sKm[n * 132 + d] = sm * (1.f / 256.f);
    }
  }
  __syncthreads();
  {
    const int q = tid >> 2, nb = (tid & 3) * 4;
    const u32x4* qp = (const u32x4*)(Q + (size_t)(q0 + q) * 128);
    float gsum[4] = {0.f, 0.f, 0.f, 0.f};
    u32x4 qrow[16];
#pragma unroll
    for (int c = 0; c < 16; ++c) qrow[c] = qp[c];
#pragma unroll
    for (int c = 0; c < 16; ++c) {
      const u32x4 u = qrow[c];
      const float qv[8] = {bf_lo(u.x), bf_hi(u.x), bf_lo(u.y), bf_hi(u.y), bf_lo(u.z), bf_hi(u.z), bf_lo(u.w), bf_hi(u.w)};
#pragma unroll
      for (int nn = 0; nn < 4; ++nn) {
        if (nb + nn < qblk) {
          const float* km = sKm + (nb + nn) * 132 + c * 8;
#pragma unroll
          for (int e = 0; e < 8; ++e) gsum[nn] += qv[e] * km[e];
        }
      }
    }
#pragma unroll
    for (int nn = 0; nn < 4; ++nn) sGate[q * 16 + nb + nn] = gsum[nn];
  }
  __syncthreads();
  if (tid < 64) {
    unsigned m = 0;
    for (int n = 0; n < qblk; ++n) {
      const float gn = sGate[tid * 16 + n];
      int rank = 0;
      for (int mm = 0; mm < qblk; ++mm) {
        const float gm = sGate[tid * 16 + mm];
        rank += (gm > gn || (gm == gn && mm < n)) ? 1 : 0;
      }
      if (rank < 3) m |= 1u << n;
    }
    sMask[tid] = m;
  }
  __syncthreads();
  const unsigned mymask = sMask[w * 16 + li];
  const int qpos = q0 + w * 16 + li;
  bf16x8 qf[4];
#pragma unroll
  for (int kk = 0; kk < 4; ++kk) qf[kk] = *(const bf16x8*)(Q + (size_t)qpos * 128 + (kk * 4 + g) * 8);
  f32x4 oacc[8];
#pragma unroll
  for (int d = 0; d < 8; ++d) oacc[d] = (f32x4){0.f, 0.f, 0.f, 0.f};
  float mrun = -INFINITY, lrun = 0.f;
  const int ntiles = qblk * 4 + qin + 1;
  const int kr = tid >> 4, kc = tid & 15;
  const int vr = tid >> 3, vc = tid & 7;
  u32x4 rkA[4], rvA[4], rkB[4], rvB[4];
#pragma unroll
  for (int i = 0; i < 4; ++i) {
    rkA[i] = *(const u32x4*)(Kp + (size_t)(kr + 16 * i) * 128 + kc * 8);
    rvA[i] = *(const u32x4*)(VT + (size_t)(vr + 32 * i) * 4096 + vc * 8);
  }
  if (ntiles > 1) {
#pragma unroll
    for (int i = 0; i < 4; ++i) {
      rkB[i] = *(const u32x4*)(Kp + (size_t)(64 + kr + 16 * i) * 128 + kc * 8);
      rvB[i] = *(const u32x4*)(VT + (size_t)(vr + 32 * i) * 4096 + 64 + vc * 8);
    }
  }
  const float SC = 0.12751743082459868f;
  auto step = [&](const int tt, u32x4 (&rk)[4], u32x4 (&rv)[4]) __attribute__((always_inline)) {
    __syncthreads();
#pragma unroll
    for (int i = 0; i < 4; ++i) {
      const int row = kr + 16 * i;
      const int f = ((row >> 3) & 3) * 4 + (row & 3);
      *(u32x4*)(sK + row * 256 + ((kc ^ f) << 4)) = rk[i];
      const int vrow = vr + 32 * i;
      *(u32x4*)(sV + vrow * 128 + ((vc ^ (vrow & 7)) << 4)) = rv[i];
    }
    __syncthreads();
    if (tt + 2 < ntiles) {
      const int k1 = (tt + 2) * 64;
#pragma unroll
      for (int i = 0; i < 4; ++i) {
        rk[i] = *(const u32x4*)(Kp + (size_t)(k1 + kr + 16 * i) * 128 + kc * 8);
        rv[i] = *(const u32x4*)(VT + (size_t)(vr + 32 * i) * 4096 + k1 + vc * 8);
      }
    }
    const int blk = tt >> 2;
    const bool own = (blk == qblk);
    const bool rowvalid = own || ((mymask >> blk) & 1u);
    if (__any(rowvalid)) {
      const int key0 = tt * 64;
      f32x4 sacc[2][2];
#pragma unroll
      for (int st = 0; st < 2; ++st)
#pragma unroll
        for (int kt = 0; kt < 2; ++kt) {
          sacc[st][kt] = (f32x4){0.f, 0.f, 0.f, 0.f};
          const int row = 32 * st + 8 * (li >> 2) + 4 * kt + (li & 3);
#pragma unroll
          for (int kk = 0; kk < 4; ++kk) {
            const bf16x8 kf = *(const bf16x8*)(sK + row * 256 + (((kk * 4 + g) ^ li) << 4));
            sacc[st][kt] = __builtin_amdgcn_mfma_f32_16x16x32_bf16(kf, qf[kk], sacc[st][kt], 0, 0, 0);
          }
        }
      const bool diag = (tt == ntiles - 1);
      float mx = -INFINITY;
      if (diag || !__all(rowvalid)) {
#pragma unroll
        for (int st = 0; st < 2; ++st)
#pragma unroll
          for (int kt = 0; kt < 2; ++kt)
#pragma unroll
            for (int r = 0; r < 4; ++r) {
              const int key = key0 + 32 * st + 8 * g + 4 * kt + r;
              bool ok = rowvalid && (!diag || key <= qpos);
              const float sv = ok ? sacc[st][kt][r] * SC : -INFINITY;
              sacc[st][kt][r] = sv;
              mx = fmaxf(mx, sv);
            }
      } else {
#pragma unroll
        for (int st = 0; st < 2; ++st)
#pragma unroll
          for (int kt = 0; kt < 2; ++kt) {
            sacc[st][kt] *= SC;
            mx = fmaxf(mx, fmaxf(fmaxf(sacc[st][kt][0], sacc[st][kt][1]), fmaxf(sacc[st][kt][2], sacc[st][kt][3])));
          }
      }
      mx = fmaxf(mx, __shfl_xor(mx, 16));
      mx = fmaxf(mx, __shfl_xor(mx, 32));
      const float mnew = (mx > mrun + 6.f) ? mx : mrun;
      const float muse = (mnew == -INFINITY) ? 0.f : mnew;
      const bool resc = __any(mnew != mrun);
      const float alpha = __builtin_amdgcn_exp2f(mrun - muse);
      mrun = mnew;
      float ps = 0.f;
      bf16x8 pf[2];
#pragma unroll
      for (int st = 0; st < 2; ++st) {
        float pv[8];
#pragma unroll
        for (int kt = 0; kt < 2; ++kt)
#pragma unroll
          for (int r = 0; r < 4; ++r) {
            const float e = __builtin_amdgcn_exp2f(sacc[st][kt][r] - muse);
            pv[kt * 4 + r] = e;
            ps += e;
          }
        u32x4 u;
        u.x = pk_bf16(pv[0], pv[1]); u.y = pk_bf16(pv[2], pv[3]); u.z = pk_bf16(pv[4], pv[5]); u.w = pk_bf16(pv[6], pv[7]);
        pf[st] = *(bf16x8*)&u;
      }
      lrun = lrun * alpha + ps;
      if (resc) {
#pragma unroll
        for (int d = 0; d < 8; ++d) oacc[d] *= alpha;
      }
#pragma unroll
      for (int d = 0; d < 8; ++d) {
        const int row = d * 16 + li;
#pragma unroll
        for (int st = 0; st < 2; ++st) {
          const bf16x8 vf = *(const bf16x8*)(sV + row * 128 + (((st * 4 + g) ^ (li & 7)) << 4));
          oacc[d] = __builtin_amdgcn_mfma_f32_16x16x32_bf16(vf, pf[st], oacc[d], 0, 0, 0);
        }
      }
    }
    };
  for (int tt = 0; tt < ntiles; tt += 2) {
    step(tt, rkA, rvA);
    if (tt + 1 < ntiles) step(tt + 1, rkB, rvB);
  }
  lrun += __shfl_xor(lrun, 16);
  lrun += __shfl_xor(lrun, 32);
  const float inv = 1.f / lrun;
  bf16_t* ao = (bf16_t*)(ws + OFF_AO) + (size_t)(b * 4096 + qpos) * 1024 + hd * 128;
#pragma unroll
  for (int d = 0; d < 8; ++d) {
    u32x2 v;
    v.x = pk_bf16(oacc[d][0] * inv, oacc[d][1] * inv);
    v.y = pk_bf16(oacc[d][2] * inv, oacc[d][3] * inv);
    *(u32x2*)(ao + d * 16 + g * 4) = v;
  }
}

__device__ void ret_out_item(const P& p, int bh, int c) {
  char* ws = opaque(p.ws);
  const bf16_t* R = (const bf16_t*)(ws + OFF_R);
  const int b = bh >> 2, hd = bh & 3;
  const bf16_t* Q = R + R_RQ + ((size_t)bh * 4096 + c * 128) * 128;
  const bf16_t* Kp = R + R_RK + ((size_t)bh * 4096 + c * 128) * 128;
  const bf16_t* VT = R + R_RVT + (size_t)bh * 128 * 4096 + c * 128;
  const bf16_t* ST = (const bf16_t*)(ws + OFF_ST) + (size_t)(bh * 32 + c) * 16384;
  const int tid_ = otid(); const int lane = tid_ & 63, w = tid_ >> 6, li = lane & 15, g = lane >> 4;
  const float lg = LOG2G[hd];
  bf16x8 qf[2][4];
#pragma unroll
  for (int ns = 0; ns < 2; ++ns)
#pragma unroll
    for (int kk = 0; kk < 4; ++kk) qf[ns][kk] = *(const bf16x8*)(Q + (size_t)(32 * w + 16 * ns + li) * 128 + (kk * 4 + g) * 8);
  f32x4 acc[8][2];
#pragma unroll
  for (int es = 0; es < 8; ++es)
#pragma unroll
    for (int ns = 0; ns < 2; ++ns) acc[es][ns] = (f32x4){0.f, 0.f, 0.f, 0.f};
  if (c > 0) {
#pragma unroll
    for (int es = 0; es < 8; ++es)
#pragma unroll
      for (int kk = 0; kk < 4; ++kk) {
        const bf16x8 sf = *(const bf16x8*)(ST + (size_t)(es * 16 + li) * 128 + (kk * 4 + g) * 8);
#pragma unroll
        for (int ns = 0; ns < 2; ++ns) acc[es][ns] = __builtin_amdgcn_mfma_f32_16x16x32_bf16(sf, qf[ns][kk], acc[es][ns], 0, 0, 0);
      }
#pragma unroll
    for (int ns = 0; ns < 2; ++ns) {
      const float xi = exp2f((float)(32 * w + 16 * ns + li + 1) * lg);
#pragma unroll
      for (int es = 0; es < 8; ++es) {
        acc[es][ns][0] *= xi; acc[es][ns][1] *= xi; acc[es][ns][2] *= xi; acc[es][ns][3] *= xi;
      }
    }
  }
  for (int ms = 0; ms <= w; ++ms) {
    f32x4 sacc[2][2];
#pragma unroll
    for (int kt = 0; kt < 2; ++kt) {
      const int row = 32 * ms + 8 * (li >> 2) + 4 * kt + (li & 3);
#pragma unroll
      for (int ns = 0; ns < 2; ++ns) sacc[kt][ns] = (f32x4){0.f, 0.f, 0.f, 0.f};
#pragma unroll
      for (int kk = 0; kk < 4; ++kk) {
        const bf16x8 kf = *(const bf16x8*)(Kp + (size_t)row * 128 + (kk * 4 + g) * 8);
#pragma unroll
        for (int ns = 0; ns < 2; ++ns) sacc[kt][ns] = __builtin_amdgcn_mfma_f32_16x16x32_bf16(kf, qf[ns][kk], sacc[kt][ns], 0, 0, 0);
      }
    }
    bf16x8 pf[2];
#pragma unroll
    for (int ns = 0; ns < 2; ++ns) {
      const int n = 32 * w + 16 * ns + li;
      float pv[8];
#pragma unroll
      for (int kt = 0; kt < 2; ++kt)
#pragma unroll
        for (int r = 0; r < 4; ++r) {
          const int m = 32 * ms + 8 * g + 4 * kt + r;
          const float dec = (n >= m) ? exp2f((float)(n - m) * lg) : 0.f;
          pv[kt * 4 + r] = sacc[kt][ns][r] * dec;
        }
      u32x4 u;
      u.x = pk_bf16(pv[0], pv[1]); u.y = pk_bf16(pv[2], pv[3]); u.z = pk_bf16(pv[4], pv[5]); u.w = pk_bf16(pv[6], pv[7]);
      pf[ns] = *(bf16x8*)&u;
    }
#pragma unroll
    for (int es = 0; es < 8; ++es) {
      const bf16x8 vf = *(const bf16x8*)(VT + (size_t)(es * 16 + li) * 4096 + 32 * ms + 8 * g);
#pragma unroll
      for (int ns = 0; ns < 2; ++ns) acc[es][ns] = __builtin_amdgcn_mfma_f32_16x16x32_bf16(vf, pf[ns], acc[es][ns], 0, 0, 0);
    }
  }
  const bf16_t* RG = R + R_RG;
  bf16_t* ao = (bf16_t*)(ws + OFF_AO);
#pragma unroll
  for (int ns = 0; ns < 2; ++ns) {
    float ss = 0.f;
#pragma unroll
    for (int es = 0; es < 8; ++es)
#pragma unroll
      for (int r = 0; r < 4; ++r) ss += acc[es][ns][r] * acc[es][ns][r];
    ss += __shfl_xor(ss, 16);
    ss += __shfl_xor(ss, 32);
    const float rs = rsqrtf(ss * (1.f / 128.f) + 1e-6f);
    const size_t t = (size_t)b * 4096 + c * 128 + 32 * w + 16 * ns + li;
#pragma unroll
    for (int es = 0; es < 8; ++es) {
      const int e = es * 16 + g * 4;
      const u32x2 gu = *(const u32x2*)(RG + t * 512 + hd * 128 + e);
      const float gv[4] = {bf_lo(gu.x), bf_hi(gu.x), bf_lo(gu.y), bf_hi(gu.y)};
      float o[4];
#pragma unroll
      for (int r = 0; r < 4; ++r) {
        const float sg = gv[r] / (1.f + __expf(-gv[r]));
        o[r] = acc[es][ns][r] * rs * sg;
      }
      u32x2 v;
      v.x = pk_bf16(o[0], o[1]);
      v.y = pk_bf16(o[2], o[3]);
      *(u32x2*)(ao + t * 1024 + 512 + hd * 128 + e) = v;
    }
  }
}

#define CSWAP(a, b) { unsigned _h = (a) > (b) ? (a) : (b); unsigned _l = (a) > (b) ? (b) : (a); (a) = _h; (b) = _l; }

__device__ void peer_token(const P& p, int layer, int tok, bool dry, char* smem, const u32x4 (&scv)[4]) {
  char* ws = opaque(p.ws);
  const int tid_ = otid(); const int lane = tid_ & 63, li = lane & 15, rw = lane >> 4, rbase = lane & 48;
  const bf16_t* sc = (const bf16_t*)(ws + OFF_R + R_SC_BYTES) + (size_t)tok * 2048;
  unsigned res[4];
#pragma unroll
  for (int pp = 0; pp < 4; ++pp) {
    const int head = 4 * (pp >> 1) + rw, half = pp & 1, hp = head * 2 + half;
    const u32x4 a0 = scv[pp];
    unsigned k[8];
    const float vv[8] = {bf_lo(a0.x), bf_hi(a0.x), bf_lo(a0.y), bf_hi(a0.y), bf_lo(a0.z), bf_hi(a0.z), bf_lo(a0.w), bf_hi(a0.w)};
#pragma unroll
    for (int e = 0; e < 8; ++e) k[e] = (f_ord(vv[e]) & ~0x7Fu) | (unsigned)(127 - (li * 8 + e));
    CSWAP(k[0], k[1]) CSWAP(k[2], k[3]) CSWAP(k[4], k[5]) CSWAP(k[6], k[7])
    CSWAP(k[0], k[2]) CSWAP(k[1], k[3]) CSWAP(k[4], k[6]) CSWAP(k[5], k[7])
    CSWAP(k[1], k[2]) CSWAP(k[5], k[6])
    CSWAP(k[0], k[4]) CSWAP(k[1], k[5]) CSWAP(k[2], k[6]) CSWAP(k[3], k[7])
    CSWAP(k[2], k[4]) CSWAP(k[3], k[5])
    CSWAP(k[1], k[2]) CSWAP(k[3], k[4]) CSWAP(k[5], k[6])
    unsigned keep = 0;
#pragma unroll
    for (int rd = 0; rd < 16; ++rd) {
      const unsigned wk = rowmax_u(k[0]);
      if (li == rd) keep = wk;
      const bool win = (k[0] == wk);
      k[0] = win ? k[1] : k[0]; k[1] = win ? k[2] : k[1]; k[2] = win ? k[3] : k[2]; k[3] = win ? k[4] : k[3];
      k[4] = win ? k[5] : k[4]; k[5] = win ? k[6] : k[5]; k[6] = win ? k[7] : k[6]; k[7] = win ? 0u : k[7];
    }
    res[pp] = keep;
  }
  int eidx[2];
  float gate[2];
#pragma unroll
  for (int hp2 = 0; hp2 < 2; ++hp2) {
    const unsigned k1 = res[hp2 * 2], k2 = res[hp2 * 2 + 1];
    const float s1 = f_deord(k1 & ~0x7Fu), s2 = f_deord(k2 & ~0x7Fu);
    const int i1 = 127 - (int)(k1 & 0x7Fu), i2 = 127 - (int)(k2 & 0x7Fu);
    int ptr = 0;
    unsigned keep = 0;
    float s2p = __uint_as_float((unsigned)__builtin_amdgcn_ds_bpermute((rbase + 0) * 4, (int)__float_as_uint(s2)));
    unsigned hk = (f_ord(s1 + s2p) & ~0xFFu) | (unsigned)(255 - (li * 16 + 0));
#pragma unroll
    for (int rd = 0; rd < 16; ++rd) {
      const unsigned wk = rowmax_u(hk);
      if (li == rd) keep = wk;
      const bool win = (hk == wk);
      ptr += win ? 1 : 0;
      const int pcl = ptr < 15 ? ptr : 15;
      s2p = __uint_as_float((unsigned)__builtin_amdgcn_ds_bpermute((rbase + pcl) * 4, (int)__float_as_uint(s2)));
      const unsigned nk = (f_ord(s1 + s2p) & ~0xFFu) | (unsigned)(255 - (li * 16 + pcl));
      hk = win ? (ptr < 16 ? nk : 0u) : hk;
    }
    const float ts = f_deord(keep & ~0xFFu);
    const int idx8 = 255 - (int)(keep & 0xFFu);
    const int a = idx8 >> 4, bq = idx8 & 15;
    const int e1 = __builtin_amdgcn_ds_bpermute((rbase + a) * 4, i1);
    const int e2 = __builtin_amdgcn_ds_bpermute((rbase + bq) * 4, i2);
    eidx[hp2] = e1 * 128 + e2;
    const float tmax = f_deord(rowmax_u(keep) & ~0xFFu);
    const float ex = __expf(ts - tmax);
    const float sm = rowsum_f(ex);
    gate[hp2] = ex / sm;
  }
  const unsigned char* xn8 = (const unsigned char*)(ws + OFF_AO) + (32ull << 20) + (size_t)tok * 1024;
  i32x8 tq[8];
#pragma unroll
  for (int s8 = 0; s8 < 8; ++s8) {
    const u32x4 lo = *(const u32x4*)(xn8 + s8 * 128 + rw * 16);
    const u32x4 hi = *(const u32x4*)(xn8 + s8 * 128 + 64 + rw * 16);
    tq[s8] = (i32x8){(int)lo.x, (int)lo.y, (int)lo.z, (int)lo.w, (int)hi.x, (int)hi.y, (int)hi.z, (int)hi.w};
  }
  const unsigned char* U4 = (const unsigned char*)(ws + OFF_U) + (size_t)layer * 16384 * 512;
  const unsigned char* V4 = (const unsigned char*)(ws + OFF_U) + (size_t)(4 + layer) * 16384 * 512;
  const float* SU = (const float*)(ws + OFF_V) + (size_t)layer * 16384;
  const float* SV = (const float*)(ws + OFF_V) + (size_t)(4 + layer) * 16384;
  char* lw = smem + (tid_ >> 6) * 8704;
  float wreg[2];
#pragma unroll
  for (int h2 = 0; h2 < 2; ++h2) {
    const float su = SU[eidx[h2]], sv = SV[eidx[h2]];
    float hreg = 0.f;
    for (int b2 = 0; b2 < 2; ++b2) {
      u32x4 uu[16];
      const int lh = lane >> 5, l5 = lane & 31;
#pragma unroll
      for (int q = 0; q < 16; ++q) {
        const int e0 = __builtin_amdgcn_readlane(eidx[h2], b2 * 32 + 2 * q);
        const int e1 = __builtin_amdgcn_readlane(eidx[h2], b2 * 32 + 2 * q + 1);
        const int e = lh ? e1 : e0;
        uu[q] = ((const u32x4*)(U4 + (size_t)e * 512))[l5];
      }
#pragma unroll
      for (int hh = 0; hh < 2; ++hh) {
#pragma unroll
        for (int q = 0; q < 8; ++q) *(u32x4*)(lw + (2 * q + lh) * 544 + l5 * 16) = uu[hh * 8 + q];
        f32x4 acc = {0.f, 0.f, 0.f, 0.f};
#pragma unroll
        for (int s8 = 0; s8 < 8; ++s8) {
          const u32x4 a = *(const u32x4*)(lw + li * 544 + s8 * 64 + rw * 16);
          const i32x8 av = {(int)a.x, (int)a.y, (int)a.z, (int)a.w, 0, 0, 0, 0};
          acc = __builtin_amdgcn_mfma_scale_f32_16x16x128_f8f6f4(av, tq[s8], acc, 4, 0, 0, 0x7f7f7f7f, 0, 0x7f7f7f7f);
        }
        const int lr2 = li & 3;
        const float sel = lr2 == 0 ? acc[0] : lr2 == 1 ? acc[1] : lr2 == 2 ? acc[2] : acc[3];
        const float val = __uint_as_float((unsigned)__builtin_amdgcn_ds_bpermute(((li >> 2) * 16 + li) * 4, (int)__float_as_uint(sel)));
        hreg = (rw == b2 * 2 + hh) ? val : hreg;
      }
    }
    const float hid = hreg * su;
    const float ge = 0.5f * hid * (1.f + erff(hid * 0.70710678118654752f));
    wreg[h2] = gate[h2] * ge * sv;
  }
  f32x2 oa2[8];
#pragma unroll
  for (int e = 0; e < 8; ++e) oa2[e] = (f32x2){0.f, 0.f};
#pragma unroll
  for (int h2 = 0; h2 < 2; ++h2) {
    for (int jb = 0; jb < 64; jb += 16) {
      u32x2 vv[16];
#pragma unroll
      for (int q = 0; q < 16; ++q) {
        const int e = __builtin_amdgcn_readlane(eidx[h2], jb + q);
        vv[q] = ((const u32x2*)(V4 + (size_t)e * 512))[lane];
      }
#pragma unroll
      for (int q = 0; q < 16; ++q) {
        const float wq = rdlane_f(wreg[h2], jb + q);
        const f32x2 w2 = {wq, wq};
#pragma unroll
        for (int k = 0; k < 2; ++k) {
          oa2[4 * k + 0] += w2 * __builtin_amdgcn_cvt_scalef32_pk_f32_fp4(vv[q][k], 1.0f, 0);
          oa2[4 * k + 1] += w2 * __builtin_amdgcn_cvt_scalef32_pk_f32_fp4(vv[q][k], 1.0f, 1);
          oa2[4 * k + 2] += w2 * __builtin_amdgcn_cvt_scalef32_pk_f32_fp4(vv[q][k], 1.0f, 2);
          oa2[4 * k + 3] += w2 * __builtin_amdgcn_cvt_scalef32_pk_f32_fp4(vv[q][k], 1.0f, 3);
        }
      }
    }
  }
  float* hrow = (float*)(ws + OFF_H) + (size_t)tok * 1024;
  float hv[16];
#pragma unroll
  for (int k = 0; k < 4; ++k) {
    const f32x4 h4 = ((const f32x4*)hrow)[lane * 4 + k];
    hv[4 * k] = h4.x; hv[4 * k + 1] = h4.y; hv[4 * k + 2] = h4.z; hv[4 * k + 3] = h4.w;
  }
  float ss = 0.f;
#pragma unroll
  for (int e = 0; e < 8; ++e) {
    hv[2 * e] += oa2[e].x;
    hv[2 * e + 1] += oa2[e].y;
  }
#pragma unroll
  for (int e = 0; e < 16; ++e) ss += hv[e] * hv[e];
  ss = wavesum_f(ss);
  if (dry) { if (lane == 0) ((float*)(ws + OFF_S))[tok] = ss; return; }
  const float rs = rsqrtf(ss * (1.f / 1024.f) + 1e-6f);
  const float* gw = (layer < 3) ? (p.norm_mix + (size_t)(layer + 1) * 1024) : p.final_norm;
  float y[16];
#pragma unroll
  for (int k = 0; k < 4; ++k) {
    const f32x4 g4 = ((const f32x4*)gw)[lane * 4 + k];
    y[4 * k] = hv[4 * k] * rs * g4.x; y[4 * k + 1] = hv[4 * k + 1] * rs * g4.y;
    y[4 * k + 2] = hv[4 * k + 2] * rs * g4.z; y[4 * k + 3] = hv[4 * k + 3] * rs * g4.w;
  }
  if (layer < 3) {
#pragma unroll
    for (int k = 0; k < 4; ++k) ((f32x4*)hrow)[lane * 4 + k] = MAKEF4(hv[4 * k], hv[4 * k + 1], hv[4 * k + 2], hv[4 * k + 3]);
    bf16_t* xo = (bf16_t*)(ws + OFF_XN) + (size_t)tok * 1024;
    u32x4 o0, o1;
    o0.x = pk_bf16(y[0], y[1]); o0.y = pk_bf16(y[2], y[3]); o0.z = pk_bf16(y[4], y[5]); o0.w = pk_bf16(y[6], y[7]);
    o1.x = pk_bf16(y[8], y[9]); o1.y = pk_bf16(y[10], y[11]); o1.z = pk_bf16(y[12], y[13]); o1.w = pk_bf16(y[14], y[15]);
    ((u32x4*)xo)[lane * 2] = o0;
    ((u32x4*)xo)[lane * 2 + 1] = o1;
  } else {
    float* orow = p.out + (size_t)tok * 1024;
#pragma unroll
    for (int k = 0; k < 4; ++k) ((f32x4*)orow)[lane * 4 + k] = MAKEF4(y[4 * k], y[4 * k + 1], y[4 * k + 2], y[4 * k + 3]);
  }
}

__device__ void quant_rows(const float* src, unsigned char* dst, float* scales, int row_begin, int nrows) {
  const int tid_ = otid();
  const int lane = tid_ & 63, w = tid_ >> 6;
  for (int row = row_begin + blockIdx.x * 4 + w; row < nrows; row += gridDim.x * 4) {
    const f32x4* sp = (const f32x4*)(src + (size_t)row * 1024) + lane * 4;
    f32x4 v[4];
    float am = 0.f;
#pragma unroll
    for (int k = 0; k < 4; ++k) {
      v[k] = sp[k];
      am = fmaxf(am, fmaxf(fmaxf(fabsf(v[k].x), fabsf(v[k].y)), fmaxf(fabsf(v[k].z), fabsf(v[k].w))));
    }
    am = fmaxf(am, __shfl_xor(am, 1)); am = fmaxf(am, __shfl_xor(am, 2)); am = fmaxf(am, __shfl_xor(am, 4));
    am = fmaxf(am, __shfl_xor(am, 8)); am = fmaxf(am, __shfl_xor(am, 16)); am = fmaxf(am, __shfl_xor(am, 32));
    const float sc = am > 0.f ? 6.f / am : 1.f;
    u32x2 o;
#pragma unroll
    for (int k = 0; k < 2; ++k) {
      unsigned wd = 0u;
      wd = __builtin_amdgcn_cvt_scalef32_pk_fp4_f32(wd, v[2 * k].x * sc, v[2 * k].y * sc, 1.0f, 0);
      wd = __builtin_amdgcn_cvt_scalef32_pk_fp4_f32(wd, v[2 * k].z * sc, v[2 * k].w * sc, 1.0f, 1);
      wd = __builtin_amdgcn_cvt_scalef32_pk_fp4_f32(wd, v[2 * k + 1].x * sc, v[2 * k + 1].y * sc, 1.0f, 2);
      wd = __builtin_amdgcn_cvt_scalef32_pk_fp4_f32(wd, v[2 * k + 1].z * sc, v[2 * k + 1].w * sc, 1.0f, 3);
      o[k] = wd;
    }
    ((u32x2*)(dst + (size_t)row * 512))[lane] = o;
    if (lane == 0) scales[row] = am > 0.f ? am * (1.f / 6.f) : 1.f;
  }
}

__global__ void __launch_bounds__(256, 2) fwd_kernel(P p) {
  __shared__ __attribute__((aligned(16))) char smem[65536];
  cg::grid_group grid = cg::this_grid();
  char* ws = opaque(p.ws);
  if (threadIdx.x == 0) {
    ((volatile unsigned*)(smem + 65520))[0] = 0u;
    ((volatile unsigned*)(smem + 65520))[1] = 0u;
    const unsigned x = (unsigned)__builtin_amdgcn_s_getreg((3 << 11) | 20) & 0xFu;
    (void)xb_add(&((unsigned*)(ws + OFF_BAR))[XB_XCNT(x)], 1u);
  }
  __syncthreads();
  const int tid = threadIdx.x;
  const int G = gridDim.x;

  if (STOP == 0) { grid.sync(); return; }
  tr_cvt_tiles(p.even_w_in, (bf16_t*)(ws + OFF_WEIN), 1024, 3584, 2, smem);
  tr_cvt_tiles(p.even_w_out, (bf16_t*)(ws + OFF_WEOUT), 1024, 1024, 2, smem);
  tr_cvt_tiles(p.odd_w_in, (bf16_t*)(ws + OFF_WOIN), 1024, 3072, 2, smem);
  tr_cvt_tiles(p.odd_w_out, (bf16_t*)(ws + OFF_WOOUT), 1024, 1024, 2, smem);
  cvt_straight(p.peer_w_q, (bf16_t*)(ws + OFF_AO), 4ull * 1024 * 2048);
  if (STOP == -1) { grid.sync(); return; }
  cvt_straight(p.peer_sub_keys, (bf16_t*)(ws + OFF_SUBK), 4ull * 8 * 2 * 128 * 128);
  quant_rows(p.peer_u, (unsigned char*)(ws + OFF_U), (float*)(ws + OFF_V), 0, 16384);
  quant_rows(p.peer_v, (unsigned char*)(ws + OFF_U) + 4ull * 16384 * 512, (float*)(ws + OFF_V) + 65536, 0, 16384);
  if (STOP == -2) { grid.sync(); return; }
  {
    float* ctab = (float*)(ws + OFF_COS);
    float* stab = (float*)(ws + OFF_SIN);
    for (int i = blockIdx.x * 256 + tid; i < 4096 * 64; i += G * 256) {
      const int s = i >> 6, d = i & 63;
      const float inv = (float)exp2(-(double)d * (13.287712379549449 / 64.0));
      const float ang = (float)s * inv;
      const double ad = (double)ang;
      const double kq = rint(ad * 0.15915494309189535);
      const float rr = (float)(ad - kq * 6.283185307179586);
      ctab[i] = __cosf(rr);
      stab[i] = __sinf(rr);
    }
  }
  if (STOP == -3) { grid.sync(); return; }
  rmsnorm_rows(p.x, p.norm_mix, (bf16_t*)(ws + OFF_XN), (float*)(ws + OFF_H));
  if (p.out == nullptr) grid.sync();
  gbar((unsigned*)(opaque(p.ws) + OFF_BAR), (volatile unsigned*)(smem + 65520));
  if (STOP == 1) return;

  for (int layer = 0; layer < 4; ++layer) {
    const int li2 = layer >> 1;
    ws = opaque(p.ws);
    const int tid = otid();
    const bf16_t* XN = (const bf16_t*)(ws + OFF_XN);
    float* H = (float*)(ws + OFF_H);
    if ((layer & 1) == 0) {
      for (int rep = 0; rep < REP_A; ++rep)
      for (int it = blockIdx.x; it < 64 * 28; it += G) even_in_tile(p, li2, (it & 7) * 8 + (it >> 3) / 28, (it >> 3) % 28, smem);
      if (layer == 0) {
        for (int it = blockIdx.x; it < 512; it += G) {
          const int lf = it >> 7, hp = (it >> 3) & 15, kc = it & 7;
          gemm_tile_fp8out<4>((const bf16_t*)(ws + OFF_SUBK) + ((size_t)lf * 16 + hp) * 16384, 128,
                              (const bf16_t*)(ws + OFF_AO) + (size_t)lf * 1024 * 2048 + (size_t)(kc * 128) * 2048 + hp * 128, 2048, 128,
                              (unsigned char*)(ws + OFF_WPQ) + ((size_t)lf * 2048 + hp * 128) * 1024 + kc * 128, 1024, 256.f, smem);
        }
      }
      gbar((unsigned*)(opaque(p.ws) + OFF_BAR), (volatile unsigned*)(smem + 65520));
      if (STOP == 2) return;
      const int qb = (layer == 0) ? 16384 : 49152, qe = (layer == 0) ? 49152 : 65536;
      if ((blockIdx.x & 256) == 0) {
        quant_rows(p.peer_u, (unsigned char*)(ws + OFF_U), (float*)(ws + OFF_V), qb, qe);
        quant_rows(p.peer_v, (unsigned char*)(ws + OFF_U) + 4ull * 16384 * 512, (float*)(ws + OFF_V) + 65536, qb, qe);
      }
      for (int rep = 0; rep < REP_B1; ++rep)
      for (int it = blockIdx.x; it < 1024 + 512; it += G) {
        if (it < 1024) {
          const int x = it >> 4, bh = it & 15;
          const int qt = (x < 32) ? (63 - x) : (x - 32);
          moba_item(p, bh, qt, smem);
        } else {
          const int idx = it - 1024, bh = idx >> 5, c = idx & 31;
          const bf16_t* Rb = (const bf16_t*)(ws + OFF_R);
          gemm_tile_f32<false, 4>(Rb + R_RVT + (size_t)bh * 128 * 4096 + c * 128, 4096,
                               Rb + R_RKT + (size_t)bh * 128 * 4096 + c * 128, 4096, 128,
                               (float*)(ws + OFF_S) + (size_t)idx * 16384, 128, smem);
        }
      }
      if ((blockIdx.x & 256) != 0) {
        quant_rows(p.peer_u, (unsigned char*)(ws + OFF_U), (float*)(ws + OFF_V), qb, qe);
        quant_rows(p.peer_v, (unsigned char*)(ws + OFF_U) + 4ull * 16384 * 512, (float*)(ws + OFF_V) + 65536, qb, qe);
      }
      gbar((unsigned*)(opaque(p.ws) + OFF_BAR), (volatile unsigned*)(smem + 65520));
      if (STOP == 3) return;
      {
        const float* S = (const float*)(ws + OFF_S);
        bf16_t* ST = (bf16_t*)(ws + OFF_ST);
        for (int i = blockIdx.x * 256 + tid; i < 16 * 16384 / 4; i += G * 256) {
          const int bh = i >> 12, off = (i & 4095) * 4;
          const float gc = exp2f(128.f * LOG2G[bh & 3]);
          f32x4 st = {0.f, 0.f, 0.f, 0.f};
          const float* Sp = S + (size_t)(bh * 32) * 16384 + off;
          bf16_t* Tp = ST + (size_t)(bh * 32) * 16384 + off;
          for (int c0 = 0; c0 < 32; c0 += 8) {
            f32x4 a[8];
#pragma unroll
            for (int c = 0; c < 8; ++c) a[c] = *(const f32x4*)(Sp + (size_t)(c0 + c) * 16384);
#pragma unroll
            for (int c = 0; c < 8; ++c) {
              u32x2 o;
              o.x = pk_bf16(st[0], st[1]); o.y = pk_bf16(st[2], st[3]);
              *(u32x2*)(Tp + (size_t)(c0 + c) * 16384) = o;
              st = st * gc + a[c];
            }
          }
        }
      }
      gbar((unsigned*)(opaque(p.ws) + OFF_BAR), (volatile unsigned*)(smem + 65520));
      if (STOP == 4) return;
      for (int rep = 0; rep < REP_B3; ++rep)
      for (int it = blockIdx.x; it < 512; it += G) ret_out_item(p, it >> 5, it & 31);
      gbar((unsigned*)(opaque(p.ws) + OFF_BAR), (volatile unsigned*)(smem + 65520));
      if (STOP == 5) return;
      for (int it = blockIdx.x; it < 64 * 8; it += G) {
        const int tm = (it & 7) * 8 + ((it >> 3) >> 3), tn = (it >> 3) & 7;
        gemm_tile_f32<true, 8>((const bf16_t*)(ws + OFF_AO) + (size_t)tm * 256 * 1024, 1024,
                            (const bf16_t*)(ws + OFF_WEOUT) + ((size_t)li2 * 1024 + tn * 128) * 1024, 1024, 1024,
                            H + (size_t)tm * 256 * 1024 + tn * 128, 1024, smem);
      }
      gbar((unsigned*)(opaque(p.ws) + OFF_BAR), (volatile unsigned*)(smem + 65520));
      if (STOP == 6) return;
    } else {
      bf16_t* PR = (bf16_t*)(ws + OFF_R);
      for (int it = blockIdx.x; it < 64 * 24; it += G) {
        const int tm = (it & 7) * 8 + (it >> 3) / 24, tn = (it >> 3) % 24;
        gemm_tile_bf16<8>(XN + (size_t)tm * 256 * 1024, 1024,
                       (const bf16_t*)(ws + OFF_WOIN) + ((size_t)li2 * 3072 + tn * 128) * 1024, 1024, 1024,
                       PR + (size_t)tm * 256 * 3072 + tn * 128, 3072, smem);
      }
      gbar((unsigned*)(opaque(p.ws) + OFF_BAR), (volatile unsigned*)(smem + 65520));
      if (STOP == 11) return;
      {
        bf16_t* AO = (bf16_t*)(ws + OFF_AO);
        const float* cw = p.odd_conv + (size_t)li2 * 3 * 1024;
        for (int i = blockIdx.x * 256 + tid; i < T_TOK * 128; i += G * 256) {
          const int t = i >> 7, c8 = (i & 127) * 8;
          const int s = t & 4095;
          const bf16_t* row = PR + (size_t)t * 3072;
          const u32x4 bg = *(const u32x4*)(row + c8);
          float u[3][8];
#pragma unroll
          for (int dt = 0; dt < 3; ++dt) {
            if (s - dt >= 0) {
              const u32x4 cg4 = *(const u32x4*)(row - (size_t)dt * 3072 + 1024 + c8);
              const u32x4 hx4 = *(const u32x4*)(row - (size_t)dt * 3072 + 2048 + c8);
              u[dt][0] = bf_lo(cg4.x) * bf_lo(hx4.x); u[dt][1] = bf_hi(cg4.x) * bf_hi(hx4.x);
              u[dt][2] = bf_lo(cg4.y) * bf_lo(hx4.y); u[dt][3] = bf_hi(cg4.y) * bf_hi(hx4.y);
              u[dt][4] = bf_lo(cg4.z) * bf_lo(hx4.z); u[dt][5] = bf_hi(cg4.z) * bf_hi(hx4.z);
              u[dt][6] = bf_lo(cg4.w) * bf_lo(hx4.w); u[dt][7] = bf_hi(cg4.w) * bf_hi(hx4.w);
            } else {
#pragma unroll
              for (int e = 0; e < 8; ++e) u[dt][e] = 0.f;
            }
          }
          const float bgf[8] = {bf_lo(bg.x), bf_hi(bg.x), bf_lo(bg.y), bf_hi(bg.y), bf_lo(bg.z), bf_hi(bg.z), bf_lo(bg.w), bf_hi(bg.w)};
          float y[8];
#pragma unroll
          for (int e = 0; e < 8; ++e) {
            const float w0 = cw[c8 + e], w1 = cw[1024 + c8 + e], w2 = cw[2048 + c8 + e];
            y[e] = bgf[e] * (w0 * u[2][e] + w1 * u[1][e] + w2 * u[0][e]);
          }
          u32x4 o;
          o.x = pk_bf16(y[0], y[1]); o.y = pk_bf16(y[2], y[3]); o.z = pk_bf16(y[4], y[5]); o.w = pk_bf16(y[6], y[7]);
          *(u32x4*)(AO + (size_t)t * 1024 + c8) = o;
        }
      }
      gbar((unsigned*)(opaque(p.ws) + OFF_BAR), (volatile unsigned*)(smem + 65520));
      if (STOP == 12) return;
      for (int it = blockIdx.x; it < 64 * 8; it += G) {
        const int tm = (it & 7) * 8 + ((it >> 3) >> 3), tn = (it >> 3) & 7;
        gemm_tile_f32<true, 8>((const bf16_t*)(ws + OFF_AO) + (size_t)tm * 256 * 1024, 1024,
                            (const bf16_t*)(ws + OFF_WOOUT) + ((size_t)li2 * 1024 + tn * 128) * 1024, 1024, 1024,
                            H + (size_t)tm * 256 * 1024 + tn * 128, 1024, smem);
      }
      gbar((unsigned*)(opaque(p.ws) + OFF_BAR), (volatile unsigned*)(smem + 65520));
      if (STOP == 13) return;
    }
    rmsnorm_rows(H, p.norm_ffn + (size_t)layer * 1024, nullptr, nullptr, (unsigned char*)(ws + OFF_AO) + (32ull << 20));
    gbar((unsigned*)(opaque(p.ws) + OFF_BAR), (volatile unsigned*)(smem + 65520));
      if (STOP == 7) return;
    {
      bf16_t* SCB = (bf16_t*)(ws + OFF_R + R_SC_BYTES);
      for (int rep = 0; rep < REP_E; ++rep)
      for (int it = blockIdx.x; it < 64 * 16; it += G) {
        const int tm = (it & 7) * 8 + ((it >> 3) >> 4), tn = (it >> 3) & 15;
        gemm_tile_bf16<8, true>((const bf16_t*)(ws + OFF_AO + (32ull << 20)) + (size_t)tm * 256 * 512, 512,
                       (const bf16_t*)(ws + OFF_WPQ) + ((size_t)layer * 2048 + tn * 128) * 512, 512, 512,
                       SCB + (size_t)tm * 256 * 2048 + tn * 128, 2048, smem);
      }
      gbar((unsigned*)(opaque(p.ws) + OFF_BAR), (volatile unsigned*)(smem + 65520));
      if (STOP == 8) return;
    }
    for (int rep = 0; rep < REP_F; ++rep)
    {
      const int tl = otid(), wv = tl >> 6, ln = tl & 63;
      const bf16_t* scb = (const bf16_t*)(ws + OFF_R + R_SC_BYTES);
      u32x4 scn[4];
      if ((int)blockIdx.x < T_TOK / 4) {
#pragma unroll
        for (int pp = 0; pp < 4; ++pp)
          scn[pp] = *(const u32x4*)(scb + (size_t)(blockIdx.x * 4 + wv) * 2048 + ((4 * (pp >> 1) + (ln >> 4)) * 2 + (pp & 1)) * 128 + (ln & 15) * 8);
      }
      for (int it = blockIdx.x; it < T_TOK / 4; it += G) {
        u32x4 scc[4];
#pragma unroll
        for (int pp = 0; pp < 4; ++pp) scc[pp] = scn[pp];
        if (it + G < T_TOK / 4) {
#pragma unroll
          for (int pp = 0; pp < 4; ++pp)
            scn[pp] = *(const u32x4*)(scb + (size_t)((it + G) * 4 + wv) * 2048 + ((4 * (pp >> 1) + (ln >> 4)) * 2 + (pp & 1)) * 128 + (ln & 15) * 8);
        }
        peer_token(p, layer, it * 4 + wv, rep + 1 < REP_F, smem, scc);
      }
    }
    gbar((unsigned*)(opaque(p.ws) + OFF_BAR), (volatile unsigned*)(smem + 65520));
      if (STOP == 10) return;
  }
}

extern "C" void kernel_launch(void* const* d_in, const int* in_sizes, int n_in, void* d_out, int out_size, void* d_ws,
                              size_t ws_size, hipStream_t stream) {
  static int grid_blocks = 0;
  if (!grid_blocks) {
    int dev = 0, cus = 0, per_cu = 0;
    hipGetDevice(&dev);
    hipDeviceGetAttribute(&cus, hipDeviceAttributeMultiprocessorCount, dev);
    hipOccupancyMaxActiveBlocksPerMultiprocessor(&per_cu, fwd_kernel, 256, 0);
    if (per_cu > 2) per_cu = 2;
    grid_blocks = cus * per_cu;
  }
  if (ws_size < WS_NEED) {
    fprintf(stderr, "workspace too small: %zu < %zu\n", ws_size, (size_t)WS_NEED);
    return;
  }
  P p{};
  p.x = (const float*)d_in[0];
  p.norm_mix = (const float*)d_in[1];
  p.norm_ffn = (const float*)d_in[2];
  p.even_w_in = (const float*)d_in[3];
  p.even_w_out = (const float*)d_in[4];
  p.odd_w_in = (const float*)d_in[5];
  p.odd_conv = (const float*)d_in[6];
  p.odd_w_out = (const float*)d_in[7];
  p.peer_w_q = (const float*)d_in[8];
  p.peer_sub_keys = (const float*)d_in[9];
  p.peer_u = (const float*)d_in[10];
  p.peer_v = (const float*)d_in[11];
  p.final_norm = (const float*)d_in[12];
  p.out = (float*)d_out;
  p.ws = (char*)d_ws;
  (void)hipMemsetAsync(d_ws, 0, 16384, stream);
  void* args[] = {&p};
  hipError_t e = hipLaunchCooperativeKernel((void*)fwd_kernel, dim3(grid_blocks), dim3(256), args, 0, stream);
  if (e != hipSuccess) {
    fprintf(stderr, "cooperative launch failed: %s (grid %d)\n", hipGetErrorString(e), grid_blocks);
    (void)hipGetLastError();
    grid_blocks = 256;
    e = hipLaunchCooperativeKernel((void*)fwd_kernel, dim3(grid_blocks), dim3(256), args, 0, stream);
    if (e != hipSuccess) fprintf(stderr, "cooperative launch failed again: %s\n", hipGetErrorString(e));
  }
}
```

```cpp
#include <hip/hip_runtime.h>
#include <hip/hip_cooperative_groups.h>
#include <cstdio>
namespace cg = cooperative_groups;

typedef unsigned short bf16_t;
typedef short bf16x8 __attribute__((ext_vector_type(8)));
typedef float f32x4 __attribute__((ext_vector_type(4)));
typedef unsigned u32x4 __attribute__((ext_vector_type(4)));
typedef unsigned u32x2 __attribute__((ext_vector_type(2)));
typedef float f32x2 __attribute__((ext_vector_type(2)));
typedef int i32x8 __attribute__((ext_vector_type(8)));
__device__ __forceinline__ f32x4 MAKEF4(float a, float b, float c, float d) { f32x4 r = {a, b, c, d}; return r; }

#ifndef STOP
#define STOP 99
#endif
#ifndef REP_E
#define REP_E 1
#endif
#ifndef REP_B1
#define REP_B1 1
#endif
#ifndef REP_A
#define REP_A 1
#endif
#ifndef REP_B3
#define REP_B3 1
#endif
#ifndef REP_F
#define REP_F 1
#endif
#define T_TOK 16384
#define DM 1024
#define SEQL 4096

constexpr size_t OFF_BAR   = 0;
constexpr size_t OFF_COS   = 16384;
constexpr size_t OFF_SIN   = OFF_COS + 4096ull * 64 * 4;
constexpr size_t OFF_KPART = OFF_SIN + 4096ull * 64 * 4;
constexpr size_t OFF_WEIN  = OFF_KPART + 256ull * 4 * 128 * 4;
constexpr size_t OFF_WEOUT = OFF_WEIN + 2ull * 3584 * 1024 * 2;
constexpr size_t OFF_WOIN  = OFF_WEOUT + 2ull * 1024 * 2048 * 2;
constexpr size_t OFF_WOOUT = OFF_WOIN + 2ull * 3072 * 1024 * 2;
constexpr size_t OFF_WPQ   = OFF_WOOUT + 2ull * 1024 * 1024 * 2;
constexpr size_t OFF_SUBK  = OFF_WPQ + 4ull * 2048 * 1024 * 2;
constexpr size_t OFF_U     = OFF_SUBK + 4ull * 8 * 2 * 128 * 128 * 2;
constexpr size_t OFF_V     = OFF_U + 4ull * 16384 * 1024 * 2;
constexpr size_t OFF_H     = OFF_V + 4ull * 16384 * 1024 * 2;
constexpr size_t OFF_XN    = OFF_H + 16384ull * 1024 * 4;
constexpr size_t OFF_R     = OFF_XN + 16384ull * 1024 * 2;
constexpr size_t R_BYTES   = 192ull << 20;
constexpr size_t OFF_AO    = OFF_R + R_BYTES;
constexpr size_t OFF_S     = OFF_AO + 16384ull * 2048 * 2;
constexpr size_t OFF_ST    = OFF_S + 16ull * 32 * 128 * 128 * 4;
constexpr size_t WS_NEED   = OFF_ST + 16ull * 32 * 128 * 128 * 2;
constexpr size_t HEADBUF = 16ull * 4096 * 128;
constexpr size_t R_MQ = 0, R_MK = HEADBUF, R_MVT = 2 * HEADBUF, R_RQ = 3 * HEADBUF, R_RK = 4 * HEADBUF,
                 R_RKT = 5 * HEADBUF, R_RVT = 6 * HEADBUF, R_RG = 7 * HEADBUF;
constexpr size_t R_SC_BYTES = 64ull << 20;

struct P {
  const float *x, *norm_mix, *norm_ffn, *even_w_in, *even_w_out, *odd_w_in, *odd_conv, *odd_w_out,
      *peer_w_q, *peer_sub_keys, *peer_u, *peer_v, *final_norm;
  float* out;
  char* ws;
};

__device__ __forceinline__ int otid() { int t = threadIdx.x; asm volatile("" : "+v"(t)); return t; }
typedef __attribute__((address_space(1))) char gchar_t;
__device__ __forceinline__ char* opaque(char* q) { size_t z = 0; asm volatile("" : "+s"(z)); return q + z; }
typedef __bf16 bf16x2_t __attribute__((ext_vector_type(2)));
__device__ __forceinline__ unsigned pk_bf16(float lo, float hi) {
  bf16x2_t v = {(__bf16)lo, (__bf16)hi};
  return __builtin_bit_cast(unsigned, v);
}
__device__ __forceinline__ bf16_t f2bf(float f) { return (bf16_t)(pk_bf16(f, 0.f) & 0xffffu); }
__device__ __forceinline__ float bf_lo(unsigned u) { return __uint_as_float(u << 16); }
__device__ __forceinline__ float bf_hi(unsigned u) { return __uint_as_float(u & 0xffff0000u); }
__device__ __forceinline__ float bf2f(bf16_t h) { return __uint_as_float(((unsigned)h) << 16); }

template <int CTRL>
__device__ __forceinline__ unsigned dpp_u(unsigned x) {
  return (unsigned)__builtin_amdgcn_update_dpp(0, (int)x, CTRL, 0xF, 0xF, false);
}
__device__ __forceinline__ unsigned rowmax_u(unsigned x) {
  unsigned y;
  y = dpp_u<0x121>(x); x = x > y ? x : y;
  y = dpp_u<0x122>(x); x = x > y ? x : y;
  y = dpp_u<0x124>(x); x = x > y ? x : y;
  y = dpp_u<0x128>(x); x = x > y ? x : y;
  return x;
}
__device__ __forceinline__ float rowsum_f(float x) {
  x += __uint_as_float(dpp_u<0x121>(__float_as_uint(x)));
  x += __uint_as_float(dpp_u<0x122>(__float_as_uint(x)));
  x += __uint_as_float(dpp_u<0x124>(__float_as_uint(x)));
  x += __uint_as_float(dpp_u<0x128>(__float_as_uint(x)));
  return x;
}
__device__ __forceinline__ float rdlane_f(float x, int l) {
  return __uint_as_float((unsigned)__builtin_amdgcn_readlane((int)__float_as_uint(x), l));
}
__device__ __forceinline__ float wavesum_f(float x) {
  x = rowsum_f(x);
  return rdlane_f(x, 0) + rdlane_f(x, 16) + rdlane_f(x, 32) + rdlane_f(x, 48);
}
__device__ __forceinline__ unsigned f_ord(float v) {
  unsigned u = __float_as_uint(v);
  return (u & 0x80000000u) ? ~u : (u | 0x80000000u);
}
__device__ __forceinline__ float f_deord(unsigned u) {
  return __uint_as_float((u & 0x80000000u) ? (u ^ 0x80000000u) : ~u);
}

#define XB_TMO 128
#define XB_XCNT(j) (256 + 64 * (j))
#define XB_XSUB(j) (1280 + 64 * (j))
#define XB_XGEN(j) (2304 + 64 * (j))
#define XB_TOP 3328
#define XB_TOPGEN 3392
#define XB_SPIN_CAP (1u << 22)
__device__ __forceinline__ unsigned xb_ld(unsigned* q) { return __hip_atomic_load(q, __ATOMIC_RELAXED, __HIP_MEMORY_SCOPE_AGENT); }
__device__ __forceinline__ unsigned xb_add(unsigned* q, unsigned v) { return __hip_atomic_fetch_add(q, v, __ATOMIC_RELAXED, __HIP_MEMORY_SCOPE_AGENT); }
#define XB_SPIN(cond, bar) do { unsigned _sp = 0; while (cond) { __builtin_amdgcn_s_sleep(1); \
    if ((++_sp & 255u) == 0u) { if (xb_ld(&(bar)[XB_TMO])) break; if (_sp > XB_SPIN_CAP) { atomicAdd(&(bar)[XB_TMO], 1u); break; } } } } while (0)
__device__ __forceinline__ void xb_complete(unsigned* bar, unsigned x, unsigned& nloc, unsigned& nx) {
  const unsigned G = gridDim.x;
  unsigned sum, cnt, mine, sp = 0u;
  for (;;) {
    sum = 0u; cnt = 0u; mine = 0u;
#pragma unroll
    for (unsigned j = 0; j < 16; ++j) { const unsigned c = xb_ld(&bar[XB_XCNT(j)]); sum += c; cnt += (c > 0u) ? 1u : 0u; mine = (j == x) ? c : mine; }
    if (sum == G) break;
    __builtin_amdgcn_s_sleep(1);
    if ((++sp & 255u) == 0u) { if (xb_ld(&bar[XB_TMO])) break; if (sp > XB_SPIN_CAP) { atomicAdd(&bar[XB_TMO], 1u); break; } }
  }
  nloc = mine > 0u ? mine : 1u; nx = cnt > 0u ? cnt : 1u;
}
__device__ __forceinline__ void gbar(unsigned* bar, volatile unsigned* st) {
  asm volatile("s_waitcnt vmcnt(0) lgkmcnt(0)" ::: "memory");
  __syncthreads();
  if (threadIdx.x == 0) {
    const unsigned x = (unsigned)__builtin_amdgcn_s_getreg((3 << 11) | 20) & 0xFu;
    unsigned nloc = st[0], nx = st[1];
    if (nloc == 0u) { xb_complete(bar, x, nloc, nx); st[0] = nloc; st[1] = nx; }
    const unsigned old = xb_add(&bar[XB_XSUB(x)], 1u);
    const unsigned gen = old / nloc;
    if (old + 1u == (gen + 1u) * nloc) {
      __builtin_amdgcn_fence(__ATOMIC_RELEASE, "agent");
      asm volatile("s_waitcnt vmcnt(0)" ::: "memory");
      const unsigned og = xb_add(&bar[XB_TOP], 1u);
      const unsigned tg = og / nx;
      if (og + 1u == (tg + 1u) * nx) xb_add(&bar[XB_TOPGEN], 1u);
      else XB_SPIN(xb_ld(&bar[XB_TOPGEN]) == tg, bar);
      __builtin_amdgcn_fence(__ATOMIC_ACQUIRE, "agent");
      xb_add(&bar[XB_XGEN(x)], 1u);
      asm volatile("s_waitcnt vmcnt(0)" ::: "memory");
    } else {
      XB_SPIN(xb_ld(&bar[XB_XGEN(x)]) == gen, bar);
      __builtin_amdgcn_fence(__ATOMIC_ACQUIRE, "agent");
      asm volatile("s_waitcnt vmcnt(0)" ::: "memory");
    }
  }
  __syncthreads();
}

template <int MI, bool SWAP, bool F8 = false>
__device__ __forceinline__ void gemm_core(const bf16_t* __restrict__ A, int lda, const bf16_t* __restrict__ B, int ldb,
                                          int K, char* smem, f32x4 (&acc)[MI][4]) {
  const int tid = otid(), lane = tid & 63, w = tid >> 6, wm = w >> 1, wn = w & 1;
  const int lr = tid >> 3, lc = tid & 7;
  const int li = lane & 15, g = lane >> 4;
  u32x4 ra[MI], rb[4];
  const bf16_t* ap = A + (size_t)lr * lda + lc * 8;
  const bf16_t* bp = B + (size_t)lr * ldb + lc * 8;
#pragma unroll
  for (int i = 0; i < MI; ++i)
#pragma unroll
    for (int j = 0; j < 4; ++j) acc[i][j] = (f32x4){0.f, 0.f, 0.f, 0.f};
  const int nk = K >> 6;
#pragma unroll
  for (int i = 0; i < MI; ++i) ra[i] = *(const u32x4*)(ap + (size_t)(32 * i) * lda);
#pragma unroll
  for (int i = 0; i < 4; ++i) rb[i] = *(const u32x4*)(bp + (size_t)(32 * i) * ldb);
  const int woff = lr * 128 + ((lc ^ (lr & 7)) << 4);
  const int xrow = (wm * 16 * MI + li) * 128;
  const int wrow = 32768 + (wn * 32 + li) * 128;
  for (int kt = 0; kt < nk; ++kt) {
    __syncthreads();
#pragma unroll
    for (int i = 0; i < MI; ++i) *(u32x4*)(smem + woff + i * 4096) = ra[i];
#pragma unroll
    for (int i = 0; i < 4; ++i) *(u32x4*)(smem + 32768 + woff + i * 4096) = rb[i];
    __syncthreads();
    if (kt + 1 < nk) {
#pragma unroll
      for (int i = 0; i < MI; ++i) ra[i] = *(const u32x4*)(ap + (size_t)(32 * i) * lda + (kt + 1) * 64);
#pragma unroll
      for (int i = 0; i < 4; ++i) rb[i] = *(const u32x4*)(bp + (size_t)(32 * i) * ldb + (kt + 1) * 64);
    }
    if (F8) {
      const int c0 = (g ^ (li & 7)) << 4, c1 = ((4 + g) ^ (li & 7)) << 4;
      i32x8 wf8[4];
#pragma unroll
      for (int j = 0; j < 4; ++j) {
        const char* rp = smem + wrow + ((j & 1) * 16 + (j >> 1) * 64) * 128;
        const u32x4 lo = *(const u32x4*)(rp + c0), hi = *(const u32x4*)(rp + c1);
        wf8[j] = (i32x8){(int)lo.x, (int)lo.y, (int)lo.z, (int)lo.w, (int)hi.x, (int)hi.y, (int)hi.z, (int)hi.w};
      }
#pragma unroll
      for (int i = 0; i < MI; ++i) {
        const char* rp = smem + xrow + i * 2048;
        const u32x4 lo = *(const u32x4*)(rp + c0), hi = *(const u32x4*)(rp + c1);
        const i32x8 xf8 = {(int)lo.x, (int)lo.y, (int)lo.z, (int)lo.w, (int)hi.x, (int)hi.y, (int)hi.z, (int)hi.w};
#pragma unroll
        for (int j = 0; j < 4; ++j)
          acc[i][j] = __builtin_amdgcn_mfma_scale_f32_16x16x128_f8f6f4(wf8[j], xf8, acc[i][j], 0, 0, 0, 0x77777777, 0, 0x7f7f7f7f);
      }
    } else {
#pragma unroll
    for (int kk = 0; kk < 2; ++kk) {
      const int ch = ((kk * 4 + g) ^ (li & 7)) << 4;
      bf16x8 xf[MI], wf[4];
#pragma unroll
      for (int j = 0; j < 4; ++j) wf[j] = *(const bf16x8*)(smem + wrow + ((j & 1) * 16 + (j >> 1) * 64) * 128 + ch);
#pragma unroll
      for (int i = 0; i < MI; ++i) xf[i] = *(const bf16x8*)(smem + xrow + i * 2048 + ch);
#pragma unroll
      for (int i = 0; i < MI; ++i)
#pragma unroll
        for (int j = 0; j < 4; ++j) {
          if (SWAP) acc[i][j] = __builtin_amdgcn_mfma_f32_16x16x32_bf16(xf[i], wf[j], acc[i][j], 0, 0, 0);
          else acc[i][j] = __builtin_amdgcn_mfma_f32_16x16x32_bf16(wf[j], xf[i], acc[i][j], 0, 0, 0);
        }
    }
    }
  }
}

#define EPI_COORDS                                                             \
  const int tid_ = otid(); const int lane = tid_ & 63, w = tid_ >> 6, wm = w >> 1, wn = w & 1; \
  const int li = lane & 15, g = lane >> 4;                                     \
  (void)wm; (void)wn; (void)li; (void)g;
#define NCOL(j) (((j) & 1) * 16 + wn * 32 + ((j) >> 1) * 64 + g * 4)
#define MROW(i) (wm * 16 * MI + (i) * 16 + li)
#define NCOLS(j) (((j) & 1) * 16 + wn * 32 + ((j) >> 1) * 64 + li)
#define MROWS(i) (wm * 16 * MI + (i) * 16 + g * 4)

template <int MI, bool F8 = false>
__device__ void gemm_tile_bf16(const bf16_t* A, int lda, const bf16_t* B, int ldb, int K, bf16_t* C, int ldc, char* smem) {
  f32x4 acc[MI][4];
  gemm_core<MI, false, F8>(A, lda, B, ldb, K, smem, acc);
  EPI_COORDS
#pragma unroll
  for (int i = 0; i < MI; ++i)
#pragma unroll
    for (int j = 0; j < 4; ++j) {
      u32x2 v;
      v.x = pk_bf16(acc[i][j][0], acc[i][j][1]);
      v.y = pk_bf16(acc[i][j][2], acc[i][j][3]);
      *(u32x2*)(C + (size_t)MROW(i) * ldc + NCOL(j)) = v;
    }
}
template <int MI>
__device__ void gemm_tile_fp8out(const bf16_t* A, int lda, const bf16_t* B, int ldb, int K, unsigned char* C, int ldc, float mul, char* smem) {
  f32x4 acc[MI][4];
  gemm_core<MI, false>(A, lda, B, ldb, K, smem, acc);
  EPI_COORDS
#pragma unroll
  for (int i = 0; i < MI; ++i)
#pragma unroll
    for (int j = 0; j < 4; ++j) {
      int wd = __builtin_amdgcn_cvt_pk_fp8_f32(acc[i][j][0] * mul, acc[i][j][1] * mul, 0, false);
      wd = __builtin_amdgcn_cvt_pk_fp8_f32(acc[i][j][2] * mul, acc[i][j][3] * mul, wd, true);
      *(int*)(C + (size_t)MROW(i) * ldc + NCOL(j)) = wd;
    }
}
template <bool ACCUM, int MI>
__device__ void gemm_tile_f32(const bf16_t* A, int lda, const bf16_t* B, int ldb, int K, float* C, int ldc, char* smem) {
  f32x4 acc[MI][4];
  gemm_core<MI, false>(A, lda, B, ldb, K, smem, acc);
  EPI_COORDS
#pragma unroll
  for (int i = 0; i < MI; ++i)
#pragma unroll
    for (int j = 0; j < 4; ++j) {
      f32x4* cp = (f32x4*)(C + (size_t)MROW(i) * ldc + NCOL(j));
      f32x4 v = acc[i][j];
      if (ACCUM) v += *cp;
      *cp = v;
    }
}

__device__ __constant__ float LOG2G[4] = {-0.04580368961312479f, -0.02272007650008353f, -0.011315313227834146f,
                                          -0.005646563141142063f};

__device__ void even_in_tile(const P& p, int li_even, int tm, int tn, char* smem) {
  constexpr int MI = 8;
  char* ws = opaque(p.ws);
  const bf16_t* A = (const bf16_t*)(ws + OFF_XN) + (size_t)tm * 256 * 1024;
  const bf16_t* B = (const bf16_t*)(ws + OFF_WEIN) + ((size_t)li_even * 3584 + (size_t)tn * 128) * 1024;
  const int seg = tn >> 2, hd = tn & 3;
  const int t0 = tm * 256, b = t0 >> 12, s0 = t0 & 4095, bh = b * 4 + hd;
  bf16_t* R = (bf16_t*)(ws + OFF_R);
  f32x4 acc[MI][4];
  if (seg == 2 || seg == 5) {
    gemm_core<MI, true>(A, 1024, B, 1024, 1024, smem, acc);
    EPI_COORDS
    bf16_t* dst = R + (seg == 2 ? R_MVT : R_RVT) + (size_t)bh * 128 * 4096;
#pragma unroll
    for (int i = 0; i < MI; ++i)
#pragma unroll
      for (int j = 0; j < 4; ++j) {
        u32x2 v;
        v.x = pk_bf16(acc[i][j][0], acc[i][j][1]);
        v.y = pk_bf16(acc[i][j][2], acc[i][j][3]);
        *(u32x2*)(dst + (size_t)NCOLS(j) * 4096 + s0 + MROWS(i)) = v;
      }
    return;
  }
  gemm_core<MI, false>(A, 1024, B, 1024, 1024, smem, acc);
  EPI_COORDS
  if (seg != 6) {
    const float* ctab = (const float*)(ws + OFF_COS);
    const float* stab = (const float*)(ws + OFF_SIN);
#pragma unroll
    for (int i = 0; i < MI; ++i) {
      const int s = s0 + MROW(i);
#pragma unroll
      for (int jj = 0; jj < 2; ++jj) {
        const int d = wn * 32 + jj * 16 + g * 4;
        const f32x4 c = *(const f32x4*)(ctab + s * 64 + d);
        const f32x4 sn = *(const f32x4*)(stab + s * 64 + d);
#pragma unroll
        for (int r = 0; r < 4; ++r) {
          const float a = acc[i][jj][r], bb = acc[i][jj + 2][r];
          acc[i][jj][r] = a * c[r] - bb * sn[r];
          acc[i][jj + 2][r] = bb * c[r] + a * sn[r];
        }
      }
    }
  }
  if (seg == 1) {
#pragma unroll
    for (int ih = 0; ih < 2; ++ih) {
      float* kp = (float*)(ws + OFF_KPART) + ((size_t)(tm * 4 + wm * 2 + ih) * 4 + hd) * 128;
#pragma unroll
      for (int j = 0; j < 4; ++j)
#pragma unroll
        for (int r = 0; r < 4; ++r) {
          float sm = acc[ih * 4][j][r] + acc[ih * 4 + 1][j][r] + acc[ih * 4 + 2][j][r] + acc[ih * 4 + 3][j][r];
          sm = rowsum_f(sm);
          if (li == 0) kp[NCOL(j) + r] = sm;
        }
    }
  }
  if (seg == 4) {
#pragma unroll
    for (int i = 0; i < MI; ++i)
#pragma unroll
      for (int j = 0; j < 4; ++j) acc[i][j] *= 0.08838834764831843f;
  }
  if (seg != 6) {
    bf16_t* dst = R + (seg == 0 ? R_MQ : seg == 1 ? R_MK : seg == 3 ? R_RQ : R_RK) + (size_t)bh * 4096 * 128;
#pragma unroll
    for (int i = 0; i < MI; ++i)
#pragma unroll
      for (int j = 0; j < 4; ++j) {
        u32x2 v;
        v.x = pk_bf16(acc[i][j][0], acc[i][j][1]);
        v.y = pk_bf16(acc[i][j][2], acc[i][j][3]);
        *(u32x2*)(dst + (size_t)(s0 + MROW(i)) * 128 + NCOL(j)) = v;
      }
  }
  if (seg == 4) {
    bf16_t* dst = R + R_RKT + (size_t)bh * 128 * 4096;
    const float lg = LOG2G[hd];
#pragma unroll
    for (int i = 0; i < MI; ++i) {
      const int s = s0 + MROW(i);
      const float z = exp2f((float)(127 - (s & 127)) * lg);
#pragma unroll
      for (int j = 0; j < 4; ++j)
#pragma unroll
        for (int r = 0; r < 4; ++r) dst[(size_t)(NCOL(j) + r) * 4096 + s] = f2bf(acc[i][j][r] * z);
    }
  }
  if (seg == 6) {
    bf16_t* dst = R + R_RG;
#pragma unroll
    for (int i = 0; i < MI; ++i)
#pragma unroll
      for (int j = 0; j < 4; ++j) {
        u32x2 v;
        v.x = pk_bf16(acc[i][j][0], acc[i][j][1]);
        v.y = pk_bf16(acc[i][j][2], acc[i][j][3]);
        *(u32x2*)(dst + (size_t)(t0 + MROW(i)) * 512 + hd * 128 + NCOL(j)) = v;
      }
  }
}

__device__ void tr_cvt_tiles(const float* src, bf16_t* dst, int K, int N, int nl, char* smem) {
  float(*t)[65] = (float(*)[65])smem;
  const int tk = K >> 6, tnn = N >> 6, per = tk * tnn, total = per * nl;
  const int tid = threadIdx.x;
  for (int it = blockIdx.x; it < total; it += gridDim.x) {
    const int l = it / per, rem = it % per, kt = rem / tnn, nt = rem % tnn;
    const float* s = src + (size_t)l * K * N + (size_t)kt * 64 * N + nt * 64;
    bf16_t* d = dst + (size_t)l * K * N + (size_t)nt * 64 * K + kt * 64;
    __syncthreads();
#pragma unroll
    for (int i = 0; i < 16; ++i) {
      const int e = tid + i * 256, r = e >> 6, c = e & 63;
      t[r][c] = s[(size_t)r * N + c];
    }
    __syncthreads();
#pragma unroll
    for (int i = 0; i < 16; ++i) {
      const int e = tid + i * 256, n = e >> 6, k = e & 63;
      d[(size_t)n * K + k] = f2bf(t[k][n]);
    }
  }
}
__device__ void cvt_straight(const float* src, bf16_t* dst, size_t n) {
  const size_t n4 = n >> 2;
  for (size_t i = (size_t)blockIdx.x * 256 + threadIdx.x; i < n4; i += (size_t)gridDim.x * 256) {
    const f32x4 v = ((const f32x4*)src)[i];
    u32x2 o;
    o.x = pk_bf16(v.x, v.y);
    o.y = pk_bf16(v.z, v.w);
    ((u32x2*)dst)[i] = o;
  }
}
__device__ void rmsnorm_rows(const float* src, const float* gw, bf16_t* dst, float* copy, unsigned char* dst8 = nullptr) {
  const int tid_ = otid(); const int lane = tid_ & 63, w = tid_ >> 6;
  f32x4 gg[4];
#pragma unroll
  for (int k = 0; k < 4; ++k) gg[k] = ((const f32x4*)gw)[lane + 64 * k];
  const int stride = gridDim.x * 4;
  for (int row0 = blockIdx.x * 4 + w; row0 < T_TOK; row0 += stride * 4) {
    f32x4 v[4][4];
#pragma unroll
    for (int rr = 0; rr < 4; ++rr) {
      const int row = row0 + rr * stride;
      if (row < T_TOK) {
        const f32x4* sp = (const f32x4*)(src + (size_t)row * 1024);
#pragma unroll
        for (int k = 0; k < 4; ++k) v[rr][k] = sp[lane + 64 * k];
      }
    }
#pragma unroll
    for (int rr = 0; rr < 4; ++rr) {
      const int row = row0 + rr * stride;
      if (row < T_TOK) {
        float ss = 0.f;
#pragma unroll
        for (int k = 0; k < 4; ++k) ss += v[rr][k].x * v[rr][k].x + v[rr][k].y * v[rr][k].y + v[rr][k].z * v[rr][k].z + v[rr][k].w * v[rr][k].w;
        ss = wavesum_f(ss);
        const float rs = rsqrtf(ss * (1.f / 1024.f) + 1e-6f);
#pragma unroll
        for (int k = 0; k < 4; ++k) {
          const f32x4 y = v[rr][k] * rs * gg[k];
          u32x2 o;
          o.x = pk_bf16(y.x, y.y);
          o.y = pk_bf16(y.z, y.w);
          if (dst) ((u32x2*)(dst + (size_t)row * 1024))[lane + 64 * k] = o;
          if (dst8) {
            int wd = __builtin_amdgcn_cvt_pk_fp8_f32(y.x, y.y, 0, false);
            wd = __builtin_amdgcn_cvt_pk_fp8_f32(y.z, y.w, wd, true);
            ((int*)(dst8 + (size_t)row * 1024))[lane + 64 * k] = wd;
          }
          if (copy) ((f32x4*)(copy + (size_t)row * 1024))[lane + 64 * k] = v[rr][k];
        }
      }
    }
  }
}

__device__ void moba_item(const P& p, int bh, int qt, char* smem) {
  char* ws = opaque(p.ws);
  const bf16_t* R = (const bf16_t*)(ws + OFF_R);
  const bf16_t* Q = R + R_MQ + (size_t)bh * 4096 * 128;
  const bf16_t* Kp = R + R_MK + (size_t)bh * 4096 * 128;
  const bf16_t* VT = R + R_MVT + (size_t)bh * 128 * 4096;
  const int b = bh >> 2, hd = bh & 3;
  const int qblk = qt >> 2, qin = qt & 3;
  const int q0 = qt * 64;
  const int tid = otid(), lane = tid & 63, w = tid >> 6, li = lane & 15, g = lane >> 4;
  char* sK = smem;
  char* sV = smem + 16384;
  float* sGate = (float*)(smem + 32768);
  unsigned* sMask = (unsigned*)(smem + 36864);
  float* sKm = (float*)(smem + 37120);
  __syncthreads();
  {
    const float* kp = (const float*)(ws + OFF_KPART);
    for (int e = tid; e < qblk * 128; e += 256) {
      const int n = e >> 7, d = e & 127;
      float sm = 0.f;
#pragma unroll
      for (int x4 = 0; x4 < 4; ++x4) sm += kp[((size_t)(b * 64 + n * 4 + x4) * 4 + hd) * 128 + d];
      sKm[n * 132 + d] = sm * (1.f / 256.f);
    }
  }
  __syncthreads();
  {
    const int q = tid >> 2, nb = (tid & 3) * 4;
    const u32x4* qp = (const u32x4*)(Q + (size_t)(q0 + q) * 128);
    float gsum[4] = {0.f, 0.f, 0.f, 0.f};
    u32x4 qrow[16];
#pragma unroll
    for (int c = 0; c < 16; ++c) qrow[c] = qp[c];
#pragma unroll
    for (int c = 0; c < 16; ++c) {
      const u32x4 u = qrow[c];
      const float qv[8] = {bf_lo(u.x), bf_hi(u.x), bf_lo(u.y), bf_hi(u.y), bf_lo(u.z), bf_hi(u.z), bf_lo(u.w), bf_hi(u.w)};
#pragma unroll
      for (int nn = 0; nn < 4; ++nn) {
        if (nb + nn < qblk) {
          const float* km = sKm + (nb + nn) * 132 + c * 8;
#pragma unroll
          for (int e = 0; e < 8; ++e) gsum[nn] += qv[e] * km[e];
        }
      }
    }
#pragma unroll
    for (int nn = 0; nn < 4; ++nn) sGate[q * 16 + nb + nn] = gsum[nn];
  }
  __syncthreads();
  if (tid < 64) {
    unsigned m = 0;
    for (int n = 0; n < qblk; ++n) {
      const float gn = sGate[tid * 16 + n];
      int rank = 0;
      for (int mm = 0; mm < qblk; ++mm) {
        const float gm = sGate[tid * 16 + mm];
        rank += (gm > gn || (gm == gn && mm < n)) ? 1 : 0;
      }
      if (rank < 3) m |= 1u << n;
    }
    sMask[tid] = m;
  }
  __syncthreads();
  const unsigned mymask = sMask[w * 16 + li];
  const int qpos = q0 + w * 16 + li;
  bf16x8 qf[4];
#pragma unroll
  for (int kk = 0; kk < 4; ++kk) qf[kk] = *(const bf16x8*)(Q + (size_t)qpos * 128 + (kk * 4 + g) * 8);
  f32x4 oacc[8];
#pragma unroll
  for (int d = 0; d < 8; ++d) oacc[d] = (f32x4){0.f, 0.f, 0.f, 0.f};
  float mrun = -INFINITY, lrun = 0.f;
  const int ntiles = qblk * 4 + qin + 1;
  const int kr = tid >> 4, kc = tid & 15;
  const int vr = tid >> 3, vc = tid & 7;
  u32x4 rkA[4], rvA[4], rkB[4], rvB[4];
#pragma unroll
  for (int i = 0; i < 4; ++i) {
    rkA[i] = *(const u32x4*)(Kp + (size_t)(kr + 16 * i) * 128 + kc * 8);
    rvA[i] = *(const u32x4*)(VT + (size_t)(vr + 32 * i) * 4096 + vc * 8);
  }
  if (ntiles > 1) {
#pragma unroll
    for (int i = 0; i < 4; ++i) {
      rkB[i] = *(const u32x4*)(Kp + (size_t)(64 + kr + 16 * i) * 128 + kc * 8);
      rvB[i] = *(const u32x4*)(VT + (size_t)(vr + 32 * i) * 4096 + 64 + vc * 8);
    }
  }
  const float SC = 0.12751743082459868f;
  auto step = [&](const int tt, u32x4 (&rk)[4], u32x4 (&rv)[4]) __attribute__((always_inline)) {
    __syncthreads();
#pragma unroll
    for (int i = 0; i < 4; ++i) {
      const int row = kr + 16 * i;
      const int f = ((row >> 3) & 3) * 4 + (row & 3);
      *(u32x4*)(sK + row * 256 + ((kc ^ f) << 4)) = rk[i];
      const int vrow = vr + 32 * i;
      *(u32x4*)(sV + vrow * 128 + ((vc ^ (vrow & 7)) << 4)) = rv[i];
    }
    __syncthreads();
    if (tt + 2 < ntiles) {
      const int k1 = (tt + 2) * 64;
#pragma unroll
      for (int i = 0; i < 4; ++i) {
        rk[i] = *(const u32x4*)(Kp + (size_t)(k1 + kr + 16 * i) * 128 + kc * 8);
        rv[i] = *(const u32x4*)(VT + (size_t)(vr + 32 * i) * 4096 + k1 + vc * 8);
      }
    }
    const int blk = tt >> 2;
    const bool own = (blk == qblk);
    const bool rowvalid = own || ((mymask >> blk) & 1u);
    if (__any(rowvalid)) {
      const int key0 = tt * 64;
      f32x4 sacc[2][2];
#pragma unroll
      for (int st = 0; st < 2; ++st)
#pragma unroll
        for (int kt = 0; kt < 2; ++kt) {
          sacc[st][kt] = (f32x4){0.f, 0.f, 0.f, 0.f};
          const int row = 32 * st + 8 * (li >> 2) + 4 * kt + (li & 3);
#pragma unroll
          for (int kk = 0; kk < 4; ++kk) {
            const bf16x8 kf = *(const bf16x8*)(sK + row * 256 + (((kk * 4 + g) ^ li) << 4));
            sacc[st][kt] = __builtin_amdgcn_mfma_f32_16x16x32_bf16(kf, qf[kk], sacc[st][kt], 0, 0, 0);
          }
        }
      const bool diag = (tt == ntiles - 1);
      float mx = -INFINITY;
      if (diag || !__all(rowvalid)) {
#pragma unroll
        for (int st = 0; st < 2; ++st)
#pragma unroll
          for (int kt = 0; kt < 2; ++kt)
#pragma unroll
            for (int r = 0; r < 4; ++r) {
              const int key = key0 + 32 * st + 8 * g + 4 * kt + r;
              bool ok = rowvalid && (!diag || key <= qpos);
              const float sv = ok ? sacc[st][kt][r] * SC : -INFINITY;
              sacc[st][kt][r] = sv;
              mx = fmaxf(mx, sv);
            }
      } else {
#pragma unroll
        for (int st = 0; st < 2; ++st)
#pragma unroll
          for (int kt = 0; kt < 2; ++kt) {
            sacc[st][kt] *= SC;
            mx = fmaxf(mx, fmaxf(fmaxf(sacc[st][kt][0], sacc[st][kt][1]), fmaxf(sacc[st][kt][2], sacc[st][kt][3])));
          }
      }
      mx = fmaxf(mx, __shfl_xor(mx, 16));
      mx = fmaxf(mx, __shfl_xor(mx, 32));
      const float mnew = (mx > mrun + 6.f) ? mx : mrun;
      const float muse = (mnew == -INFINITY) ? 0.f : mnew;
      const bool resc = __any(mnew != mrun);
      const float alpha = __builtin_amdgcn_exp2f(mrun - muse);
      mrun = mnew;
      float ps = 0.f;
      bf16x8 pf[2];
#pragma unroll
      for (int st = 0; st < 2; ++st) {
        float pv[8];
#pragma unroll
        for (int kt = 0; kt < 2; ++kt)
#pragma unroll
          for (int r = 0; r < 4; ++r) {
            const float e = __builtin_amdgcn_exp2f(sacc[st][kt][r] - muse);
            pv[kt * 4 + r] = e;
            ps += e;
          }
        u32x4 u;
        u.x = pk_bf16(pv[0], pv[1]); u.y = pk_bf16(pv[2], pv[3]); u.z = pk_bf16(pv[4], pv[5]); u.w = pk_bf16(pv[6], pv[7]);
        pf[st] = *(bf16x8*)&u;
      }
      lrun = lrun * alpha + ps;
      if (resc) {
#pragma unroll
        for (int d = 0; d < 8; ++d) oacc[d] *= alpha;
      }
#pragma unroll
      for (int d = 0; d < 8; ++d) {
        const int row = d * 16 + li;
#pragma unroll
        for (int st = 0; st < 2; ++st) {
          const bf16x8 vf = *(const bf16x8*)(sV + row * 128 + (((st * 4 + g) ^ (li & 7)) << 4));
          oacc[d] = __builtin_amdgcn_mfma_f32_16x16x32_bf16(vf, pf[st], oacc[d], 0, 0, 0);
        }
      }
    }
    };
  for (int tt = 0; tt < ntiles; tt += 2) {
    step(tt, rkA, rvA);
    if (tt + 1 < ntiles) step(tt + 1, rkB, rvB);
  }
  lrun += __shfl_xor(lrun, 16);
  lrun += __shfl_xor(lrun, 32);
  const float inv = 1.f / lrun;
  bf16_t* ao = (bf16_t*)(ws + OFF_AO) + (size_t)(b * 4096 + qpos) * 1024 + hd * 128;
#pragma unroll
  for (int d = 0; d < 8; ++d) {
    u32x2 v;
    v.x = pk_bf16(oacc[d][0] * inv, oacc[d][1] * inv);
    v.y = pk_bf16(oacc[d][2] * inv, oacc[d][3] * inv);
    *(u32x2*)(ao + d * 16 + g * 4) = v;
  }
}

__device__ void ret_out_item(const P& p, int bh, int c) {
  char* ws = opaque(p.ws);
  const bf16_t* R = (const bf16_t*)(ws + OFF_R);
  const int b = bh >> 2, hd = bh & 3;
  const bf16_t* Q = R + R_RQ + ((size_t)bh * 4096 + c * 128) * 128;
  const bf16_t* Kp = R + R_RK + ((size_t)bh * 4096 + c * 128) * 128;
  const bf16_t* VT = R + R_RVT + (size_t)bh * 128 * 4096 + c * 128;
  const bf16_t* ST = (const bf16_t*)(ws + OFF_ST) + (size_t)(bh * 32 + c) * 16384;
  const int tid_ = otid(); const int lane = tid_ & 63, w = tid_ >> 6, li = lane & 15, g = lane >> 4;
  const float lg = LOG2G[hd];
  bf16x8 qf[2][4];
#pragma unroll
  for (int ns = 0; ns < 2; ++ns)
#pragma unroll
    for (int kk = 0; kk < 4; ++kk) qf[ns][kk] = *(const bf16x8*)(Q + (size_t)(32 * w + 16 * ns + li) * 128 + (kk * 4 + g) * 8);
  f32x4 acc[8][2];
#pragma unroll
  for (int es = 0; es < 8; ++es)
#pragma unroll
    for (int ns = 0; ns < 2; ++ns) acc[es][ns] = (f32x4){0.f, 0.f, 0.f, 0.f};
  if (c > 0) {
#pragma unroll
    for (int es = 0; es < 8; ++es)
#pragma unroll
      for (int kk = 0; kk < 4; ++kk) {
        const bf16x8 sf = *(const bf16x8*)(ST + (size_t)(es * 16 + li) * 128 + (kk * 4 + g) * 8);
#pragma unroll
        for (int ns = 0; ns < 2; ++ns) acc[es][ns] = __builtin_amdgcn_mfma_f32_16x16x32_bf16(sf, qf[ns][kk], acc[es][ns], 0, 0, 0);
      }
#pragma unroll
    for (int ns = 0; ns < 2; ++ns) {
      const float xi = exp2f((float)(32 * w + 16 * ns + li + 1) * lg);
#pragma unroll
      for (int es = 0; es < 8; ++es) {
        acc[es][ns][0] *= xi; acc[es][ns][1] *= xi; acc[es][ns][2] *= xi; acc[es][ns][3] *= xi;
      }
    }
  }
  for (int ms = 0; ms <= w; ++ms) {
    f32x4 sacc[2][2];
#pragma unroll
    for (int kt = 0; kt < 2; ++kt) {
      const int row = 32 * ms + 8 * (li >> 2) + 4 * kt + (li & 3);
#pragma unroll
      for (int ns = 0; ns < 2; ++ns) sacc[kt][ns] = (f32x4){0.f, 0.f, 0.f, 0.f};
#pragma unroll
      for (int kk = 0; kk < 4; ++kk) {
        const bf16x8 kf = *(const bf16x8*)(Kp + (size_t)row * 128 + (kk * 4 + g) * 8);
#pragma unroll
        for (int ns = 0; ns < 2; ++ns) sacc[kt][ns] = __builtin_amdgcn_mfma_f32_16x16x32_bf16(kf, qf[ns][kk], sacc[kt][ns], 0, 0, 0);
      }
    }
    bf16x8 pf[2];
#pragma unroll
    for (int ns = 0; ns < 2; ++ns) {
      const int n = 32 * w + 16 * ns + li;
      float pv[8];
#pragma unroll
      for (int kt = 0; kt < 2; ++kt)
#pragma unroll
        for (int r = 0; r < 4; ++r) {
          const int m = 32 * ms + 8 * g + 4 * kt + r;
          const float dec = (n >= m) ? exp2f((float)(n - m) * lg) : 0.f;
          pv[kt * 4 + r] = sacc[kt][ns][r] * dec;
        }
      u32x4 u;
      u.x = pk_bf16(pv[0], pv[1]); u.y = pk_bf16(pv[2], pv[3]); u.z = pk_bf16(pv[4], pv[5]); u.w = pk_bf16(pv[6], pv[7]);
      pf[ns] = *(bf16x8*)&u;
    }
#pragma unroll
    for (int es = 0; es < 8; ++es) {
      const bf16x8 vf = *(const bf16x8*)(VT + (size_t)(es * 16 + li) * 4096 + 32 * ms + 8 * g);
#pragma unroll
      for (int ns = 0; ns < 2; ++ns) acc[es][ns] = __builtin_amdgcn_mfma_f32_16x16x32_bf16(vf, pf[ns], acc[es][ns], 0, 0, 0);
    }
  }
  const bf16_t* RG = R + R_RG;
  bf16_t* ao = (bf16_t*)(ws + OFF_AO);
#pragma unroll
  for (int ns = 0; ns < 2; ++ns) {
    float ss = 0.f;
#pragma unroll
    for (int es = 0; es < 8; ++es)
#pragma unroll
      for (int r = 0; r < 4; ++r) ss += acc[es][ns][r] * acc[es][ns][r];
    ss += __shfl_xor(ss, 16);
    ss += __shfl_xor(ss, 32);
    const float rs = rsqrtf(ss * (1.f / 128.f) + 1e-6f);
    const size_t t = (size_t)b * 4096 + c * 128 + 32 * w + 16 * ns + li;
#pragma unroll
    for (int es = 0; es < 8; ++es) {
      const int e = es * 16 + g * 4;
      const u32x2 gu = *(const u32x2*)(RG + t * 512 + hd * 128 + e);
      const float gv[4] = {bf_lo(gu.x), bf_hi(gu.x), bf_lo(gu.y), bf_hi(gu.y)};
      float o[4];
#pragma unroll
      for (int r = 0; r < 4; ++r) {
        const float sg = gv[r] / (1.f + __expf(-gv[r]));
        o[r] = acc[es][ns][r] * rs * sg;
      }
      u32x2 v;
      v.x = pk_bf16(o[0], o[1]);
      v.y = pk_bf16(o[2], o[3]);
      *(u32x2*)(ao + t * 1024 + 512 + hd * 128 + e) = v;
    }
  }
}

#define CSWAP(a, b) { unsigned _h = (a) > (b) ? (a) : (b); unsigned _l = (a) > (b) ? (b) : (a); (a) = _h; (b) = _l; }

__device__ void peer_u(const P& p, int layer, int tok, char* smem, const u32x4 (&scv)[4]) {
  char* ws = opaque(p.ws);
  const int tid_ = otid(); const int lane = tid_ & 63, li = lane & 15, rw = lane >> 4, rbase = lane & 48;
  const bf16_t* sc = (const bf16_t*)(ws + OFF_R + R_SC_BYTES) + (size_t)tok * 2048;
  unsigned res[4];
#pragma unroll
  for (int pp = 0; pp < 4; ++pp) {
    const int head = 4 * (pp >> 1) + rw, half = pp & 1, hp = head * 2 + half;
    const u32x4 a0 = scv[pp];
    unsigned k[8];
    const float vv[8] = {bf_lo(a0.x), bf_hi(a0.x), bf_lo(a0.y), bf_hi(a0.y), bf_lo(a0.z), bf_hi(a0.z), bf_lo(a0.w), bf_hi(a0.w)};
#pragma unroll
    for (int e = 0; e < 8; ++e) k[e] = (f_ord(vv[e]) & ~0x7Fu) | (unsigned)(127 - (li * 8 + e));
    CSWAP(k[0], k[1]) CSWAP(k[2], k[3]) CSWAP(k[4], k[5]) CSWAP(k[6], k[7])
    CSWAP(k[0], k[2]) CSWAP(k[1], k[3]) CSWAP(k[4], k[6]) CSWAP(k[5], k[7])
    CSWAP(k[1], k[2]) CSWAP(k[5], k[6])
    CSWAP(k[0], k[4]) CSWAP(k[1], k[5]) CSWAP(k[2], k[6]) CSWAP(k[3], k[7])
    CSWAP(k[2], k[4]) CSWAP(k[3], k[5])
    CSWAP(k[1], k[2]) CSWAP(k[3], k[4]) CSWAP(k[5], k[6])
    unsigned keep = 0;
#pragma unroll
    for (int rd = 0; rd < 16; ++rd) {
      const unsigned wk = rowmax_u(k[0]);
      if (li == rd) keep = wk;
      const bool win = (k[0] == wk);
      k[0] = win ? k[1] : k[0]; k[1] = win ? k[2] : k[1]; k[2] = win ? k[3] : k[2]; k[3] = win ? k[4] : k[3];
      k[4] = win ? k[5] : k[4]; k[5] = win ? k[6] : k[5]; k[6] = win ? k[7] : k[6]; k[7] = win ? 0u : k[7];
    }
    res[pp] = keep;
  }
  int eidx[2];
  float gate[2];
#pragma unroll
  for (int hp2 = 0; hp2 < 2; ++hp2) {
    const unsigned k1 = res[hp2 * 2], k2 = res[hp2 * 2 + 1];
    const float s1 = f_deord(k1 & ~0x7Fu), s2 = f_deord(k2 & ~0x7Fu);
    const int i1 = 127 - (int)(k1 & 0x7Fu), i2 = 127 - (int)(k2 & 0x7Fu);
    int ptr = 0;
    unsigned keep = 0;
    float s2p = __uint_as_float((unsigned)__builtin_amdgcn_ds_bpermute((rbase + 0) * 4, (int)__float_as_uint(s2)));
    unsigned hk = (f_ord(s1 + s2p) & ~0xFFu) | (unsigned)(255 - (li * 16 + 0));
#pragma unroll
    for (int rd = 0; rd < 16; ++rd) {
      const unsigned wk = rowmax_u(hk);
      if (li == rd) keep = wk;
      const bool win = (hk == wk);
      ptr += win ? 1 : 0;
      const int pcl = ptr < 15 ? ptr : 15;
      s2p = __uint_as_float((unsigned)__builtin_amdgcn_ds_bpermute((rbase + pcl) * 4, (int)__float_as_uint(s2)));
      const unsigned nk = (f_ord(s1 + s2p) & ~0xFFu) | (unsigned)(255 - (li * 16 + pcl));
      hk = win ? (ptr < 16 ? nk : 0u) : hk;
    }
    const float ts = f_deord(keep & ~0xFFu);
    const int idx8 = 255 - (int)(keep & 0xFFu);
    const int a = idx8 >> 4, bq = idx8 & 15;
    const int e1 = __builtin_amdgcn_ds_bpermute((rbase + a) * 4, i1);
    const int e2 = __builtin_amdgcn_ds_bpermute((rbase + bq) * 4, i2);
    eidx[hp2] = e1 * 128 + e2;
    const float tmax = f_deord(rowmax_u(keep) & ~0xFFu);
    const float ex = __expf(ts - tmax);
    const float sm = rowsum_f(ex);
    gate[hp2] = ex / sm;
  }
  const unsigned char* xn8 = (const unsigned char*)(ws + OFF_AO) + (32ull << 20) + (size_t)tok * 1024;
  i32x8 tq[8];
#pragma unroll
  for (int s8 = 0; s8 < 8; ++s8) {
    const u32x4 lo = *(const u32x4*)(xn8 + s8 * 128 + rw * 16);
    const u32x4 hi = *(const u32x4*)(xn8 + s8 * 128 + 64 + rw * 16);
    tq[s8] = (i32x8){(int)lo.x, (int)lo.y, (int)lo.z, (int)lo.w, (int)hi.x, (int)hi.y, (int)hi.z, (int)hi.w};
  }
  const unsigned char* U4 = (const unsigned char*)(ws + OFF_U) + (size_t)layer * 16384 * 512;
  const unsigned char* V4 = (const unsigned char*)(ws + OFF_U) + (size_t)(4 + layer) * 16384 * 512;
  const float* SU = (const float*)(ws + OFF_V) + (size_t)layer * 16384;
  const float* SV = (const float*)(ws + OFF_V) + (size_t)(4 + layer) * 16384;
  char* lw = smem + (tid_ >> 6) * 8704;
  float wreg[2];
#pragma unroll
  for (int h2 = 0; h2 < 2; ++h2) {
    const float su = SU[eidx[h2]], sv = SV[eidx[h2]];
    float hreg = 0.f;
    for (int b2 = 0; b2 < 2; ++b2) {
      u32x4 uu[16];
      const int lh = lane >> 5, l5 = lane & 31;
#pragma unroll
      for (int q = 0; q < 16; ++q) {
        const int e0 = __builtin_amdgcn_readlane(eidx[h2], b2 * 32 + 2 * q);
        const int e1 = __builtin_amdgcn_readlane(eidx[h2], b2 * 32 + 2 * q + 1);
        const int e = lh ? e1 : e0;
        uu[q] = ((const u32x4*)(U4 + (size_t)e * 512))[l5];
      }
#pragma unroll
      for (int hh = 0; hh < 2; ++hh) {
#pragma unroll
        for (int q = 0; q < 8; ++q) *(u32x4*)(lw + (2 * q + lh) * 544 + l5 * 16) = uu[hh * 8 + q];
        f32x4 acc = {0.f, 0.f, 0.f, 0.f};
#pragma unroll
        for (int s8 = 0; s8 < 8; ++s8) {
          const u32x4 a = *(const u32x4*)(lw + li * 544 + s8 * 64 + rw * 16);
          const i32x8 av = {(int)a.x, (int)a.y, (int)a.z, (int)a.w, 0, 0, 0, 0};
          acc = __builtin_amdgcn_mfma_scale_f32_16x16x128_f8f6f4(av, tq[s8], acc, 4, 0, 0, 0x7f7f7f7f, 0, 0x7f7f7f7f);
        }
        const int lr2 = li & 3;
        const float sel = lr2 == 0 ? acc[0] : lr2 == 1 ? acc[1] : lr2 == 2 ? acc[2] : acc[3];
        const float val = __uint_as_float((unsigned)__builtin_amdgcn_ds_bpermute(((li >> 2) * 16 + li) * 4, (int)__float_as_uint(sel)));
        hreg = (rw == b2 * 2 + hh) ? val : hreg;
      }
    }
    const float hid = hreg * su;
    const float ge = 0.5f * hid * (1.f + erff(hid * 0.70710678118654752f));
    wreg[h2] = gate[h2] * ge * sv;
  }
  {
    int* rt = (int*)(ws + OFF_S) + (size_t)tok * 256;
    rt[lane] = eidx[0]; rt[64 + lane] = eidx[1];
    ((float*)rt)[128 + lane] = wreg[0]; ((float*)rt)[192 + lane] = wreg[1];
  }
}

__device__ void peer_v(const P& p, int layer, int tok, bool dry) {
  char* ws = opaque(p.ws);
  const int tid_ = otid(); const int lane = tid_ & 63;
  const unsigned char* V4 = (const unsigned char*)(ws + OFF_U) + (size_t)(4 + layer) * 16384 * 512;
  int eidx[2];
  float wreg[2];
  {
    const int* rt = (const int*)(ws + OFF_S) + (size_t)tok * 256;
    eidx[0] = rt[lane]; eidx[1] = rt[64 + lane];
    wreg[0] = ((const float*)rt)[128 + lane]; wreg[1] = ((const float*)rt)[192 + lane];
  }
  f32x2 oa2[8];
#pragma unroll
  for (int e = 0; e < 8; ++e) oa2[e] = (f32x2){0.f, 0.f};
#pragma unroll
  for (int h2 = 0; h2 < 2; ++h2) {
    for (int jb = 0; jb < 64; jb += 16) {
      u32x2 vv[16];
#pragma unroll
      for (int q = 0; q < 16; ++q) {
        const int e = __builtin_amdgcn_readlane(eidx[h2], jb + q);
        vv[q] = ((const u32x2*)(V4 + (size_t)e * 512))[lane];
      }
#pragma unroll
      for (int q = 0; q < 16; ++q) {
        const float wq = rdlane_f(wreg[h2], jb + q);
        const f32x2 w2 = {wq, wq};
#pragma unroll
        for (int k = 0; k < 2; ++k) {
          oa2[4 * k + 0] += w2 * __builtin_amdgcn_cvt_scalef32_pk_f32_fp4(vv[q][k], 1.0f, 0);
          oa2[4 * k + 1] += w2 * __builtin_amdgcn_cvt_scalef32_pk_f32_fp4(vv[q][k], 1.0f, 1);
          oa2[4 * k + 2] += w2 * __builtin_amdgcn_cvt_scalef32_pk_f32_fp4(vv[q][k], 1.0f, 2);
          oa2[4 * k + 3] += w2 * __builtin_amdgcn_cvt_scalef32_pk_f32_fp4(vv[q][k], 1.0f, 3);
        }
      }
    }
  }
  float* hrow = (float*)(ws + OFF_H) + (size_t)tok * 1024;
  float hv[16];
#pragma unroll
  for (int k = 0; k < 4; ++k) {
    const f32x4 h4 = ((const f32x4*)hrow)[lane * 4 + k];
    hv[4 * k] = h4.x; hv[4 * k + 1] = h4.y; hv[4 * k + 2] = h4.z; hv[4 * k + 3] = h4.w;
  }
  float ss = 0.f;
#pragma unroll
  for (int e = 0; e < 8; ++e) {
    hv[2 * e] += oa2[e].x;
    hv[2 * e + 1] += oa2[e].y;
  }
#pragma unroll
  for (int e = 0; e < 16; ++e) ss += hv[e] * hv[e];
  ss = wavesum_f(ss);
  if (dry) { if (lane == 0) ((float*)(ws + OFF_ST))[tok] = ss; return; }
  const float rs = rsqrtf(ss * (1.f / 1024.f) + 1e-6f);
  const float* gw = (layer < 3) ? (p.norm_mix + (size_t)(layer + 1) * 1024) : p.final_norm;
  float y[16];
#pragma unroll
  for (int k = 0; k < 4; ++k) {
    const f32x4 g4 = ((const f32x4*)gw)[lane * 4 + k];
    y[4 * k] = hv[4 * k] * rs * g4.x; y[4 * k + 1] = hv[4 * k + 1] * rs * g4.y;
    y[4 * k + 2] = hv[4 * k + 2] * rs * g4.z; y[4 * k + 3] = hv[4 * k + 3] * rs * g4.w;
  }
  if (layer < 3) {
#pragma unroll
    for (int k = 0; k < 4; ++k) ((f32x4*)hrow)[lane * 4 + k] = MAKEF4(hv[4 * k], hv[4 * k + 1], hv[4 * k + 2], hv[4 * k + 3]);
    bf16_t* xo = (bf16_t*)(ws + OFF_XN) + (size_t)tok * 1024;
    u32x4 o0, o1;
    o0.x = pk_bf16(y[0], y[1]); o0.y = pk_bf16(y[2], y[3]); o0.z = pk_bf16(y[4], y[5]); o0.w = pk_bf16(y[6], y[7]);
    o1.x = pk_bf16(y[8], y[9]); o1.y = pk_bf16(y[10], y[11]); o1.z = pk_bf16(y[12], y[13]); o1.w = pk_bf16(y[14], y[15]);
    ((u32x4*)xo)[lane * 2] = o0;
    ((u32x4*)xo)[lane * 2 + 1] = o1;
  } else {
    float* orow = p.out + (size_t)tok * 1024;
#pragma unroll
    for (int k = 0; k < 4; ++k) ((f32x4*)orow)[lane * 4 + k] = MAKEF4(y[4 * k], y[4 * k + 1], y[4 * k + 2], y[4 * k + 3]);
  }
}

__device__ void quant_rows(const float* src, unsigned char* dst, float* scales, int row_begin, int nrows) {
  const int tid_ = otid();
  const int lane = tid_ & 63, w = tid_ >> 6;
  for (int row = row_begin + blockIdx.x * 4 + w; row < nrows; row += gridDim.x * 4) {
    const f32x4* sp = (const f32x4*)(src + (size_t)row * 1024) + lane * 4;
    f32x4 v[4];
    float am = 0.f;
#pragma unroll
    for (int k = 0; k < 4; ++k) {
      v[k] = sp[k];
      am = fmaxf(am, fmaxf(fmaxf(fabsf(v[k].x), fabsf(v[k].y)), fmaxf(fabsf(v[k].z), fabsf(v[k].w))));
    }
    am = fmaxf(am, __shfl_xor(am, 1)); am = fmaxf(am, __shfl_xor(am, 2)); am = fmaxf(am, __shfl_xor(am, 4));
    am = fmaxf(am, __shfl_xor(am, 8)); am = fmaxf(am, __shfl_xor(am, 16)); am = fmaxf(am, __shfl_xor(am, 32));
    const float sc = am > 0.f ? 6.f / am : 1.f;
    u32x2 o;
#pragma unroll
    for (int k = 0; k < 2; ++k) {
      unsigned wd = 0u;
      wd = __builtin_amdgcn_cvt_scalef32_pk_fp4_f32(wd, v[2 * k].x * sc, v[2 * k].y * sc, 1.0f, 0);
      wd = __builtin_amdgcn_cvt_scalef32_pk_fp4_f32(wd, v[2 * k].z * sc, v[2 * k].w * sc, 1.0f, 1);
      wd = __builtin_amdgcn_cvt_scalef32_pk_fp4_f32(wd, v[2 * k + 1].x * sc, v[2 * k + 1].y * sc, 1.0f, 2);
      wd = __builtin_amdgcn_cvt_scalef32_pk_fp4_f32(wd, v[2 * k + 1].z * sc, v[2 * k + 1].w * sc, 1.0f, 3);
      o[k] = wd;
    }
    ((u32x2*)(dst + (size_t)row * 512))[lane] = o;
    if (lane == 0) scales[row] = am > 0.f ? am * (1.f / 6.f) : 1.f;
  }
}

__global__ void __launch_bounds__(256, 2) fwd_kernel(P p) {
  __shared__ __attribute__((aligned(16))) char smem[65536];
  cg::grid_group grid = cg::this_grid();
  char* ws = opaque(p.ws);
  if (threadIdx.x == 0) {
    ((volatile unsigned*)(smem + 65520))[0] = 0u;
    ((volatile unsigned*)(smem + 65520))[1] = 0u;
    const unsigned x = (unsigned)__builtin_amdgcn_s_getreg((3 << 11) | 20) & 0xFu;
    (void)xb_add(&((unsigned*)(ws + OFF_BAR))[XB_XCNT(x)], 1u);
  }
  __syncthreads();
  const int tid = threadIdx.x;
  const int G = gridDim.x;

  if (STOP == 0) { grid.sync(); return; }
  tr_cvt_tiles(p.even_w_in, (bf16_t*)(ws + OFF_WEIN), 1024, 3584, 2, smem);
  tr_cvt_tiles(p.even_w_out, (bf16_t*)(ws + OFF_WEOUT), 1024, 1024, 2, smem);
  tr_cvt_tiles(p.odd_w_in, (bf16_t*)(ws + OFF_WOIN), 1024, 3072, 2, smem);
  tr_cvt_tiles(p.odd_w_out, (bf16_t*)(ws + OFF_WOOUT), 1024, 1024, 2, smem);
  cvt_straight(p.peer_w_q, (bf16_t*)(ws + OFF_AO), 4ull * 1024 * 2048);
  if (STOP == -1) { grid.sync(); return; }
  cvt_straight(p.peer_sub_keys, (bf16_t*)(ws + OFF_SUBK), 4ull * 8 * 2 * 128 * 128);
  quant_rows(p.peer_u, (unsigned char*)(ws + OFF_U), (float*)(ws + OFF_V), 0, 16384);
  quant_rows(p.peer_v, (unsigned char*)(ws + OFF_U) + 4ull * 16384 * 512, (float*)(ws + OFF_V) + 65536, 0, 16384);
  if (STOP == -2) { grid.sync(); return; }
  {
    float* ctab = (float*)(ws + OFF_COS);
    float* stab = (float*)(ws + OFF_SIN);
    for (int i = blockIdx.x * 256 + tid; i < 4096 * 64; i += G * 256) {
      const int s = i >> 6, d = i & 63;
      const float inv = (float)exp2(-(double)d * (13.287712379549449 / 64.0));
      const float ang = (float)s * inv;
      const double ad = (double)ang;
      const double kq = rint(ad * 0.15915494309189535);
      const float rr = (float)(ad - kq * 6.283185307179586);
      ctab[i] = __cosf(rr);
      stab[i] = __sinf(rr);
    }
  }
  if (STOP == -3) { grid.sync(); return; }
  rmsnorm_rows(p.x, p.norm_mix, (bf16_t*)(ws + OFF_XN), (float*)(ws + OFF_H));
  if (p.out == nullptr) grid.sync();
  gbar((unsigned*)(opaque(p.ws) + OFF_BAR), (volatile unsigned*)(smem + 65520));
  if (STOP == 1) return;

  for (int layer = 0; layer < 4; ++layer) {
    const int li2 = layer >> 1;
    ws = opaque(p.ws);
    const int tid = otid();
    const bf16_t* XN = (const bf16_t*)(ws + OFF_XN);
    float* H = (float*)(ws + OFF_H);
    if ((layer & 1) == 0) {
      for (int rep = 0; rep < REP_A; ++rep)
      for (int it = blockIdx.x; it < 64 * 28; it += G) even_in_tile(p, li2, (it & 7) * 8 + (it >> 3) / 28, (it >> 3) % 28, smem);
      if (layer == 0) {
        for (int it = blockIdx.x; it < 512; it += G) {
          const int lf = it >> 7, hp = (it >> 3) & 15, kc = it & 7;
          gemm_tile_fp8out<4>((const bf16_t*)(ws + OFF_SUBK) + ((size_t)lf * 16 + hp) * 16384, 128,
                              (const bf16_t*)(ws + OFF_AO) + (size_t)lf * 1024 * 2048 + (size_t)(kc * 128) * 2048 + hp * 128, 2048, 128,
                              (unsigned char*)(ws + OFF_WPQ) + ((size_t)lf * 2048 + hp * 128) * 1024 + kc * 128, 1024, 256.f, smem);
        }
      }
      gbar((unsigned*)(opaque(p.ws) + OFF_BAR), (volatile unsigned*)(smem + 65520));
      if (STOP == 2) return;
      const int qb = (layer == 0) ? 16384 : 49152, qe = (layer == 0) ? 49152 : 65536;
      if ((blockIdx.x & 256) == 0) {
        quant_rows(p.peer_u, (unsigned char*)(ws + OFF_U), (float*)(ws + OFF_V), qb, qe);
        quant_rows(p.peer_v, (unsigned char*)(ws + OFF_U) + 4ull * 16384 * 512, (float*)(ws + OFF_V) + 65536, qb, qe);
      }
      for (int rep = 0; rep < REP_B1; ++rep)
      for (int it = blockIdx.x; it < 1024 + 512; it += G) {
        if (it < 1024) {
          const int x = it >> 4, bh = it & 15;
          const int qt = (x < 32) ? (63 - x) : (x - 32);
          moba_item(p, bh, qt, smem);
        } else {
          const int idx = it - 1024, bh = idx >> 5, c = idx & 31;
          const bf16_t* Rb = (const bf16_t*)(ws + OFF_R);
          gemm_tile_f32<false, 4>(Rb + R_RVT + (size_t)bh * 128 * 4096 + c * 128, 4096,
                               Rb + R_RKT + (size_t)bh * 128 * 4096 + c * 128, 4096, 128,
                               (float*)(ws + OFF_S) + (size_t)idx * 16384, 128, smem);
        }
      }
      if ((blockIdx.x & 256) != 0) {
        quant_rows(p.peer_u, (unsigned char*)(ws + OFF_U), (float*)(ws + OFF_V), qb, qe);
        quant_rows(p.peer_v, (unsigned char*)(ws + OFF_U) + 4ull * 16384 * 512, (float*)(ws + OFF_V) + 65536, qb, qe);
      }
      gbar((unsigned*)(opaque(p.ws) + OFF_BAR), (volatile unsigned*)(smem + 65520));
      if (STOP == 3) return;
      {
        const float* S = (const float*)(ws + OFF_S);
        bf16_t* ST = (bf16_t*)(ws + OFF_ST);
        for (int i = blockIdx.x * 256 + tid; i < 16 * 16384 / 4; i += G * 256) {
          const int bh = i >> 12, off = (i & 4095) * 4;
          const float gc = exp2f(128.f * LOG2G[bh & 3]);
          f32x4 st = {0.f, 0.f, 0.f, 0.f};
          const float* Sp = S + (size_t)(bh * 32) * 16384 + off;
          bf16_t* Tp = ST + (size_t)(bh * 32) * 16384 + off;
          for (int c0 = 0; c0 < 32; c0 += 8) {
            f32x4 a[8];
#pragma unroll
            for (int c = 0; c < 8; ++c) a[c] = *(const f32x4*)(Sp + (size_t)(c0 + c) * 16384);
#pragma unroll
            for (int c = 0; c < 8; ++c) {
              u32x2 o;
              o.x = pk_bf16(st[0], st[1]); o.y = pk_bf16(st[2], st[3]);
              *(u32x2*)(Tp + (size_t)(c0 + c) * 16384) = o;
              st = st * gc + a[c];
            }
          }
        }
      }
      gbar((unsigned*)(opaque(p.ws) + OFF_BAR), (volatile unsigned*)(smem + 65520));
      if (STOP == 4) return;
      for (int rep = 0; rep < REP_B3; ++rep)
      for (int it = blockIdx.x; it < 512; it += G) ret_out_item(p, it >> 5, it & 31);
      gbar((unsigned*)(opaque(p.ws) + OFF_BAR), (volatile unsigned*)(smem + 65520));
      if (STOP == 5) return;
      for (int it = blockIdx.x; it < 64 * 8; it += G) {
        const int tm = (it & 7) * 8 + ((it >> 3) >> 3), tn = (it >> 3) & 7;
        gemm_tile_f32<true, 8>((const bf16_t*)(ws + OFF_AO) + (size_t)tm * 256 * 1024, 1024,
                            (const bf16_t*)(ws + OFF_WEOUT) + ((size_t)li2 * 1024 + tn * 128) * 1024, 1024, 1024,
                            H + (size_t)tm * 256 * 1024 + tn * 128, 1024, smem);
      }
      gbar((unsigned*)(opaque(p.ws) + OFF_BAR), (volatile unsigned*)(smem + 65520));
      if (STOP == 6) return;
    } else {
      bf16_t* PR = (bf16_t*)(ws + OFF_R);
      for (int it = blockIdx.x; it < 64 * 24; it += G) {
        const int tm = (it & 7) * 8 + (it >> 3) / 24, tn = (it >> 3) % 24;
        gemm_tile_bf16<8>(XN + (size_t)tm * 256 * 1024, 1024,
                       (const bf16_t*)(ws + OFF_WOIN) + ((size_t)li2 * 3072 + tn * 128) * 1024, 1024, 1024,
                       PR + (size_t)tm * 256 * 3072 + tn * 128, 3072, smem);
      }
      gbar((unsigned*)(opaque(p.ws) + OFF_BAR), (volatile unsigned*)(smem + 65520));
      if (STOP == 11) return;
      {
        bf16_t* AO = (bf16_t*)(ws + OFF_AO);
        const float* cw = p.odd_conv + (size_t)li2 * 3 * 1024;
        for (int i = blockIdx.x * 256 + tid; i < T_TOK * 128; i += G * 256) {
          const int t = i >> 7, c8 = (i & 127) * 8;
          const int s = t & 4095;
          const bf16_t* row = PR + (size_t)t * 3072;
          const u32x4 bg = *(const u32x4*)(row + c8);
          float u[3][8];
#pragma unroll
          for (int dt = 0; dt < 3; ++dt) {
            if (s - dt >= 0) {
              const u32x4 cg4 = *(const u32x4*)(row - (size_t)dt * 3072 + 1024 + c8);
              const u32x4 hx4 = *(const u32x4*)(row - (size_t)dt * 3072 + 2048 + c8);
              u[dt][0] = bf_lo(cg4.x) * bf_lo(hx4.x); u[dt][1] = bf_hi(cg4.x) * bf_hi(hx4.x);
              u[dt][2] = bf_lo(cg4.y) * bf_lo(hx4.y); u[dt][3] = bf_hi(cg4.y) * bf_hi(hx4.y);
              u[dt][4] = bf_lo(cg4.z) * bf_lo(hx4.z); u[dt][5] = bf_hi(cg4.z) * bf_hi(hx4.z);
              u[dt][6] = bf_lo(cg4.w) * bf_lo(hx4.w); u[dt][7] = bf_hi(cg4.w) * bf_hi(hx4.w);
            } else {
#pragma unroll
              for (int e = 0; e < 8; ++e) u[dt][e] = 0.f;
            }
          }
          const float bgf[8] = {bf_lo(bg.x), bf_hi(bg.x), bf_lo(bg.y), bf_hi(bg.y), bf_lo(bg.z), bf_hi(bg.z), bf_lo(bg.w), bf_hi(bg.w)};
          float y[8];
#pragma unroll
          for (int e = 0; e < 8; ++e) {
            const float w0 = cw[c8 + e], w1 = cw[1024 + c8 + e], w2 = cw[2048 + c8 + e];
            y[e] = bgf[e] * (w0 * u[2][e] + w1 * u[1][e] + w2 * u[0][e]);
          }
          u32x4 o;
          o.x = pk_bf16(y[0], y[1]); o.y = pk_bf16(y[2], y[3]); o.z = pk_bf16(y[4], y[5]); o.w = pk_bf16(y[6], y[7]);
          *(u32x4*)(AO + (size_t)t * 1024 + c8) = o;
        }
      }
      gbar((unsigned*)(opaque(p.ws) + OFF_BAR), (volatile unsigned*)(smem + 65520));
      if (STOP == 12) return;
      for (int it = blockIdx.x; it < 64 * 8; it += G) {
        const int tm = (it & 7) * 8 + ((it >> 3) >> 3), tn = (it >> 3) & 7;
        gemm_tile_f32<true, 8>((const bf16_t*)(ws + OFF_AO) + (size_t)tm * 256 * 1024, 1024,
                            (const bf16_t*)(ws + OFF_WOOUT) + ((size_t)li2 * 1024 + tn * 128) * 1024, 1024, 1024,
                            H + (size_t)tm * 256 * 1024 + tn * 128, 1024, smem);
      }
      gbar((unsigned*)(opaque(p.ws) + OFF_BAR), (volatile unsigned*)(smem + 65520));
      if (STOP == 13) return;
    }
    rmsnorm_rows(H, p.norm_ffn + (size_t)layer * 1024, nullptr, nullptr, (unsigned char*)(ws + OFF_AO) + (32ull << 20));
    gbar((unsigned*)(opaque(p.ws) + OFF_BAR), (volatile unsigned*)(smem + 65520));
      if (STOP == 7) return;
    {
      bf16_t* SCB = (bf16_t*)(ws + OFF_R + R_SC_BYTES);
      for (int rep = 0; rep < REP_E; ++rep)
      for (int it = blockIdx.x; it < 64 * 16; it += G) {
        const int tm = (it & 7) * 8 + ((it >> 3) >> 4), tn = (it >> 3) & 15;
        gemm_tile_bf16<8, true>((const bf16_t*)(ws + OFF_AO + (32ull << 20)) + (size_t)tm * 256 * 512, 512,
                       (const bf16_t*)(ws + OFF_WPQ) + ((size_t)layer * 2048 + tn * 128) * 512, 512, 512,
                       SCB + (size_t)tm * 256 * 2048 + tn * 128, 2048, smem);
      }
      gbar((unsigned*)(opaque(p.ws) + OFF_BAR), (volatile unsigned*)(smem + 65520));
      if (STOP == 8) return;
    }
    for (int rep = 0; rep < REP_F; ++rep)
    {
      const int tl = otid(), wv = tl >> 6, ln = tl & 63;
      const bf16_t* scb = (const bf16_t*)(ws + OFF_R + R_SC_BYTES);
      u32x4 scn[4];
      if ((int)blockIdx.x < T_TOK / 4) {
#pragma unroll
        for (int pp = 0; pp < 4; ++pp)
          scn[pp] = *(const u32x4*)(scb + (size_t)(blockIdx.x * 4 + wv) * 2048 + ((4 * (pp >> 1) + (ln >> 4)) * 2 + (pp & 1)) * 128 + (ln & 15) * 8);
      }
      for (int it = blockIdx.x; it < T_TOK / 4; it += G) {
        u32x4 scc[4];
#pragma unroll
        for (int pp = 0; pp < 4; ++pp) scc[pp] = scn[pp];
        if (it + G < T_TOK / 4) {
#pragma unroll
          for (int pp = 0; pp < 4; ++pp)
            scn[pp] = *(const u32x4*)(scb + (size_t)((it + G) * 4 + wv) * 2048 + ((4 * (pp >> 1) + (ln >> 4)) * 2 + (pp & 1)) * 128 + (ln & 15) * 8);
        }
        peer_u(p, layer, it * 4 + wv, smem, scc);
      }
      for (int it = blockIdx.x; it < T_TOK / 4; it += G) peer_v(p, layer, it * 4 + wv, rep + 1 < REP_F);
    }
    gbar((unsigned*)(opaque(p.ws) + OFF_BAR), (volatile unsigned*)(smem + 65520));
      if (STOP == 10) return;
  }
}

extern "C" void kernel_launch(void* const* d_in, const int* in_sizes, int n_in, void* d_out, int out_size, void* d_ws,
                              size_t ws_size, hipStream_t stream) {
  static int grid_blocks = 0;
  if (!grid_blocks) {
    int dev = 0, cus = 0, per_cu = 0;
    hipGetDevice(&dev);
    hipDeviceGetAttribute(&cus, hipDeviceAttributeMultiprocessorCount, dev);
    hipOccupancyMaxActiveBlocksPerMultiprocessor(&per_cu, fwd_kernel, 256, 0);
    if (per_cu > 2) per_cu = 2;
    grid_blocks = cus * per_cu;
  }
  if (ws_size < WS_NEED) {
    fprintf(stderr, "workspace too small: %zu < %zu\n", ws_size, (size_t)WS_NEED);
    return;
  }
  P p{};
  p.x = (const float*)d_in[0];
  p.norm_mix = (const float*)d_in[1];
  p.norm_ffn = (const float*)d_in[2];
  p.even_w_in = (const float*)d_in[3];
  p.even_w_out = (const float*)d_in[4];
  p.odd_w_in = (const float*)d_in[5];
  p.odd_conv = (const float*)d_in[6];
  p.odd_w_out = (const float*)d_in[7];
  p.peer_w_q = (const float*)d_in[8];
  p.peer_sub_keys = (const float*)d_in[9];
  p.peer_u = (const float*)d_in[10];
  p.peer_v = (const float*)d_in[11];
  p.final_norm = (const float*)d_in[12];
  p.out = (float*)d_out;
  p.ws = (char*)d_ws;
  (void)hipMemsetAsync(d_ws, 0, 16384, stream);
  void* args[] = {&p};
  hipError_t e = hipLaunchCooperativeKernel((void*)fwd_kernel, dim3(grid_blocks), dim3(256), args, 0, stream);
  if (e != hipSuccess) {
    fprintf(stderr, "cooperative launch failed: %s (grid %d)\n", hipGetErrorString(e), grid_blocks);
    (void)hipGetLastError();
    grid_blocks = 256;
    e = hipLaunchCooperativeKernel((void*)fwd_kernel, dim3(grid_blocks), dim3(256), args, 0, stream);
    if (e != hipSuccess) fprintf(stderr, "cooperative launch failed again: %s\n", hipGetErrorString(e));
  }
}
```
